# Optimizing an MI355X kernel written in HIP

```python
import math
import jax, jax.numpy as jnp
from jax import lax
import numpy as np

D_MODEL = 2048
BATCH = 2
SEQ = 4096
DEPTH = 4

GRID_W = 64
N_BRANCH = 4
BRANCH_W = D_MODEL // N_BRANCH
SHORT_CONV = 3
HEAD_DIM = 64
N_Q_HEADS = BRANCH_W // HEAD_DIM
N_KV_HEADS = 2
KV_W = N_KV_HEADS * HEAD_DIM
Q_BLOCK = 128
ROPE_THETA = 10000.0
RWKV_N = 64
RWKV_H = BRANCH_W // RWKV_N
DECAY_LORA = 96
ICLR_LORA = 96
LONG_CONV = 31
RMS_EPS = 1e-6
GN_EPS = 64e-5
LN_EPS = 1e-5

SPLIT_SIZES = (
    BRANCH_W, BRANCH_W, BRANCH_W, BRANCH_W,
    BRANCH_W, KV_W, KV_W, BRANCH_W,
    BRANCH_W, BRANCH_W, BRANCH_W, BRANCH_W,
    BRANCH_W, BRANCH_W, BRANCH_W,
    N_BRANCH * D_MODEL,
)
P_IN = 13 * BRANCH_W + 2 * KV_W + N_BRANCH * D_MODEL

kernel_name = "bidir_parallel_hybrid_conv_gqa_rwkv7_conformer"


def rms_norm(x, g, eps=RMS_EPS):
    xf = x.astype(jnp.float32)
    y = xf * lax.rsqrt(jnp.mean(xf * xf, axis=-1, keepdims=True) + eps)
    return (y * g.astype(jnp.float32)).astype(x.dtype)


def split_cols(proj):
    out, start = [], 0
    for n in SPLIT_SIZES:
        out.append(proj[..., start:start + n])
        start += n
    return out


def depthwise_conv(u, w):
    k = w.shape[0]
    return lax.conv_general_dilated(
        u, w[:, None, :].astype(u.dtype), window_strides=(1,),
        padding=[(k // 2, k // 2)], dimension_numbers=("NWC", "WIO", "NWC"),
        feature_group_count=u.shape[-1])


def axial_angles(seq_len):
    rows = seq_len // GRID_W
    row = jnp.repeat(jnp.arange(rows), GRID_W).astype(jnp.float32)
    col = jnp.tile(jnp.arange(GRID_W), rows).astype(jnp.float32)
    n = HEAD_DIM // 4
    inv = ROPE_THETA ** (-jnp.arange(n, dtype=jnp.float32) / n)
    return row[:, None] * inv, col[:, None] * inv


def rope_pair(x, ang):
    x1, x2 = jnp.split(x, 2, axis=-1)
    c = jnp.cos(ang)[:, None, :]
    s = jnp.sin(ang)[:, None, :]
    return jnp.concatenate([x1 * c - x2 * s, x2 * c + x1 * s], axis=-1)


def axial_rope(x, ang_row, ang_col):
    xf = x.astype(jnp.float32)
    xr, xc = jnp.split(xf, 2, axis=-1)
    return jnp.concatenate([rope_pair(xr, ang_row), rope_pair(xc, ang_col)], axis=-1).astype(x.dtype)


def gqa_attention(q, k, v):
    b, s, _, d = q.shape
    g = N_Q_HEADS // N_KV_HEADS
    nb = s // Q_BLOCK
    qb = q.reshape(b, nb, Q_BLOCK, N_KV_HEADS, g, d).transpose(1, 0, 2, 3, 4, 5)
    kf = k.astype(jnp.float32)
    vf = v.astype(jnp.float32)
    scale = 1.0 / math.sqrt(d)

    def block(qi):
        sc = jnp.einsum('bqhgd,bkhd->bhgqk', qi.astype(jnp.float32), kf) * scale
        p = jax.nn.softmax(sc, axis=-1)
        return jnp.einsum('bhgqk,bkhd->bqhgd', p, vf).astype(q.dtype)

    o = lax.map(block, qb)
    return o.transpose(1, 0, 2, 3, 4, 5).reshape(b, s, N_Q_HEADS * d)


def to_dirs(u):
    return jnp.stack([u, jnp.flip(u, axis=1)])


def dirs_flip(u2):
    return jnp.stack([u2[0], jnp.flip(u2[1], axis=1)])


def shift_prev(u2):
    return jnp.pad(u2, ((0, 0), (0, 0), (1, 0), (0, 0)))[:, :, :-1]


def rwkv7_bidir(h, r, k, v, w0, w_lora_a, w_lora_b, a0, a_lora_a, a_lora_b,
                mu_rkv, k_k, k_a, r_k, gn_g, gn_b):
    dt = r.dtype
    f32 = jnp.float32
    b, s, c = r.shape
    hf = h.astype(f32)
    r2, k2, v2 = to_dirs(r.astype(f32)), to_dirs(k.astype(f32)), to_dirs(v.astype(f32))
    mu = mu_rkv.astype(f32)
    r2 = r2 + (shift_prev(r2) - r2) * mu[:, 0][:, None, None, :]
    k2 = k2 + (shift_prev(k2) - k2) * mu[:, 1][:, None, None, :]
    v2 = v2 + (shift_prev(v2) - v2) * mu[:, 2][:, None, None, :]
    wl = w0.astype(f32)[:, None, None, :] + jnp.einsum(
        'ebsr,erc->ebsc', jnp.tanh(jnp.einsum('bsd,edr->ebsr', hf, w_lora_a.astype(f32))),
        w_lora_b.astype(f32))
    wl = dirs_flip(wl)
    decay = jnp.exp(-jnp.exp(-jax.nn.softplus(-wl) - 0.5))
    a = jax.nn.sigmoid(a0.astype(f32)[:, None, None, :] + jnp.einsum(
        'ebsr,erc->ebsc', jnp.einsum('bsd,edr->ebsr', hf, a_lora_a.astype(f32)),
        a_lora_b.astype(f32)))
    a = dirs_flip(a)

    hd = lambda u: u.reshape(2, b, s, RWKV_H, RWKV_N)
    r2, k2, v2, decay, a = hd(r2), hd(k2), hd(v2), hd(decay), hd(a)
    k_k_h = k_k.astype(f32).reshape(RWKV_H, RWKV_N)
    k_a_h = k_a.astype(f32).reshape(RWKV_H, RWKV_N)
    kk = k2 * k_k_h
    kk = kk / jnp.maximum(jnp.sqrt(jnp.sum(kk * kk, axis=-1, keepdims=True)), 1e-12)
    kt = k2 * (1.0 + (a - 1.0) * k_a_h)

    tm = lambda u: jnp.moveaxis(u, 2, 0)

    def step(state, inp):
        r_t, w_t, k_t, v_t, kk_t, a_t = inp
        sa = jnp.einsum('ebhvk,ebhk->ebhv', state, -kk_t)
        state = (state * w_t[..., None, :] + sa[..., :, None] * (kk_t * a_t)[..., None, :]
                 + v_t[..., :, None] * k_t[..., None, :])
        return state, jnp.einsum('ebhvk,ebhk->ebhv', state, r_t)

    s0 = jnp.zeros((2, b, RWKV_H, RWKV_N, RWKV_N), f32)
    _, y = lax.scan(step, s0, (tm(r2), tm(decay), tm(kt), tm(v2), tm(kk), tm(a)))
    y = jnp.moveaxis(y, 0, 2)
    mean = jnp.mean(y, axis=-1, keepdims=True)
    var = jnp.mean(jnp.square(y - mean), axis=-1, keepdims=True)
    yn = ((y - mean) * lax.rsqrt(var + GN_EPS)).reshape(2, b, s, c)
    yn = yn * gn_g.astype(f32) + gn_b.astype(f32)
    bonus = jnp.sum(r2 * kt * r_k.astype(f32), axis=-1, keepdims=True) * v2
    out = dirs_flip(yn + bonus.reshape(2, b, s, c))
    return (out[0] + out[1]).astype(dt)


def hybrid_layer(x, ang_row, ang_col, norm_g, w_in, b_gate, conv_a_w, q_norm_g, k_norm_g,
                 w0, w_lora_a, w_lora_b, a0, a_lora_a, a_lora_b, mu_rkv, k_k, k_a, r_k,
                 gn_g, gn_b, dw_w, dw_b, ln_g, ln_b, w_branch, w_out):
    b, s, _ = x.shape
    h = rms_norm(x, norm_g)
    proj = h @ w_in
    (a_bg, a_cg, a_x, a_z, q, k, v, b_z, c_r, c_k, c_v, c_z,
     d_val, d_gate, d_z, gates) = split_cols(proj)

    ya = a_bg * depthwise_conv(a_cg * a_x, conv_a_w)
    ya = ya * jax.nn.silu(a_z)

    qh = rms_norm(q.reshape(b, s, N_Q_HEADS, HEAD_DIM), q_norm_g)
    kh = rms_norm(k.reshape(b, s, N_KV_HEADS, HEAD_DIM), k_norm_g)
    qh = axial_rope(qh, ang_row, ang_col)
    kh = axial_rope(kh, ang_row, ang_col)
    yb = gqa_attention(qh, kh, v.reshape(b, s, N_KV_HEADS, HEAD_DIM))
    yb = yb * jax.nn.silu(b_z)

    yc = rwkv7_bidir(h, c_r, c_k, c_v, w0, w_lora_a, w_lora_b, a0, a_lora_a, a_lora_b,
                     mu_rkv, k_k, k_a, r_k, gn_g, gn_b)
    yc = yc * jax.nn.silu(c_z)

    u = d_val * jax.nn.sigmoid(d_gate)
    u = depthwise_conv(u, dw_w) + dw_b
    uf = u.astype(jnp.float32)
    mean = jnp.mean(uf, axis=-1, keepdims=True)
    var = jnp.mean(jnp.square(uf - mean), axis=-1, keepdims=True)
    un = ((uf - mean) * lax.rsqrt(var + LN_EPS) * ln_g.astype(jnp.float32)
          + ln_b.astype(jnp.float32)).astype(u.dtype)
    yd = jax.nn.silu(un) * jax.nn.silu(d_z)

    ys = jnp.stack([ya, yb, yc, yd], axis=2)
    bp = jnp.einsum('bskc,kcd->bskd', ys, w_branch)
    g = jax.nn.sigmoid(gates.reshape(b, s, N_BRANCH, D_MODEL) + b_gate)
    merged = jnp.sum(g * bp, axis=2)
    return x + merged @ w_out


def setup_inputs(seed: int = 0) -> dict:
    key = jax.random.key(seed)
    ks = jax.random.split(key, 32)
    L, D, W = DEPTH, D_MODEL, BRANCH_W
    nrm = lambda i, shape, scale: jax.random.normal(ks[i], shape, jnp.float32) * scale
    uni = lambda i, shape, lo, hi: jax.random.uniform(ks[i], shape, jnp.float32, lo, hi)
    return {
        "x": nrm(0, (BATCH, SEQ, D), 1.0),
        "norm_g": 1.0 + nrm(1, (L, D), 0.02),
        "w_in": nrm(2, (L, D, P_IN), D ** -0.5),
        "b_gate": nrm(3, (L, N_BRANCH, D), 0.1),
        "conv_a_w": nrm(4, (L, SHORT_CONV, W), SHORT_CONV ** -0.5),
        "q_norm_g": 1.0 + nrm(5, (L, HEAD_DIM), 0.02),
        "k_norm_g": 1.0 + nrm(6, (L, HEAD_DIM), 0.02),
        "w0": uni(7, (L, 2, W), -5.0, 1.0),
        "w_lora_a": nrm(8, (L, 2, D, DECAY_LORA), D ** -0.5),
        "w_lora_b": nrm(9, (L, 2, DECAY_LORA, W), 0.1 * DECAY_LORA ** -0.5),
        "a0": nrm(10, (L, 2, W), 0.1),
        "a_lora_a": nrm(11, (L, 2, D, ICLR_LORA), D ** -0.5),
        "a_lora_b": nrm(12, (L, 2, ICLR_LORA, W), 0.1 * ICLR_LORA ** -0.5),
        "mu_rkv": uni(13, (L, 2, 3, W), 0.0, 1.0),
        "k_k": 0.85 + nrm(14, (L, W), 0.05),
        "k_a": 1.0 + nrm(15, (L, W), 0.05),
        "r_k": nrm(16, (L, RWKV_H, RWKV_N), 0.1),
        "gn_g": 1.0 + nrm(17, (L, W), 0.02),
        "gn_b": nrm(18, (L, W), 0.02),
        "dw_w": nrm(19, (L, LONG_CONV, W), LONG_CONV ** -0.5),
        "dw_b": nrm(20, (L, W), 0.02),
        "ln_g": 1.0 + nrm(21, (L, W), 0.02),
        "ln_b": nrm(22, (L, W), 0.02),
        "w_branch": nrm(23, (L, N_BRANCH, W, D), W ** -0.5),
        "w_out": nrm(24, (L, D, D), 0.5 * D ** -0.5),
        "final_norm_g": 1.0 + nrm(25, (D,), 0.02),
    }


def reference(x, norm_g, w_in, b_gate, conv_a_w, q_norm_g, k_norm_g, w0, w_lora_a, w_lora_b,
              a0, a_lora_a, a_lora_b, mu_rkv, k_k, k_a, r_k, gn_g, gn_b, dw_w, dw_b,
              ln_g, ln_b, w_branch, w_out, final_norm_g):
    ang_row, ang_col = axial_angles(x.shape[1])
    for l in range(DEPTH):
        x = hybrid_layer(x, ang_row, ang_col, norm_g[l], w_in[l], b_gate[l], conv_a_w[l],
                         q_norm_g[l], k_norm_g[l], w0[l], w_lora_a[l], w_lora_b[l], a0[l],
                         a_lora_a[l], a_lora_b[l], mu_rkv[l], k_k[l], k_a[l], r_k[l],
                         gn_g[l], gn_b[l], dw_w[l], dw_b[l], ln_g[l], ln_b[l],
                         w_branch[l], w_out[l])
    return rms_norm(x, final_norm_g)
```

```cpp
#include <hip/hip_runtime.h>
#include <hip/hip_bf16.h>
#include <stdint.h>
#include <stdio.h>

typedef unsigned short bf16_t;
typedef short bf16x8 __attribute__((ext_vector_type(8)));
typedef float f32x4 __attribute__((ext_vector_type(4)));
typedef float f32x16 __attribute__((ext_vector_type(16)));
typedef unsigned u32x4 __attribute__((ext_vector_type(4)));
typedef unsigned u32x2 __attribute__((ext_vector_type(2)));

#define DI __device__ __forceinline__

constexpr int DM = 2048, BATCH = 2, SEQ = 4096, T = BATCH * SEQ, DEPTH = 4, BW = 512;
constexpr int NP = 15616, PIN = 15104;
constexpr int NTH = 512;
constexpr int C_ABG = 0, C_ACG = 512, C_AX = 1024, C_AZ = 1536, C_Q = 2048, C_K = 2560, C_V = 2688, C_BZ = 2816,
              C_CR = 3328, C_CK = 3840, C_CV = 4352, C_CZ = 4864, C_DV = 5376, C_DG = 5888, C_DZ = 6400, C_GATE = 6912;

struct P {
  const float *x, *norm_g, *w_in, *b_gate, *conv_a_w, *q_norm_g, *k_norm_g, *w0, *w_lora_a, *w_lora_b, *a0, *a_lora_a,
      *a_lora_b, *mu_rkv, *k_k, *k_a, *r_k, *gn_g, *gn_b, *dw_w, *dw_b, *ln_g, *ln_b, *w_branch, *w_out, *final_norm_g;
  float* out;
  bf16_t *WtIn, *WtBr, *WtOut, *WtLb, *h, *proj, *qn, *kn, *vT, *ys, *mergedb;
  float *lw, *SI, *bonusv, *yraw, *ubuf, *mergedf, *xbuf;
};

DI float bf2f(bf16_t v) { return __uint_as_float(((unsigned)v) << 16); }
DI unsigned pk2(float lo, float hi) {
  typedef __bf16 bf2 __attribute__((ext_vector_type(2)));
  typedef float f2 __attribute__((ext_vector_type(2)));
  f2 v = {lo, hi};
  bf2 r = __builtin_convertvector(v, bf2);
  return __builtin_bit_cast(unsigned, r);
}
DI bf16_t f2bf(float x) { return (bf16_t)(pk2(x, 0.f) & 0xffffu); }
DI float sigmoidf_(float x) { return 1.f / (1.f + __expf(-x)); }
DI float siluf_(float x) { return x * sigmoidf_(x); }
DI float wave_sum(float v) {
#pragma unroll
  for (int o = 1; o < 64; o <<= 1) v += __shfl_xor(v, o);
  return v;
}
DI float wave_max(float v) {
#pragma unroll
  for (int o = 1; o < 64; o <<= 1) v = fmaxf(v, __shfl_xor(v, o));
  return v;
}
template <int CTRL> DI float dppf(float x) {
  return __int_as_float(__builtin_amdgcn_update_dpp(0, __float_as_int(x), CTRL, 0xf, 0xf, true));
}
DI float red16(float x) {
  x += dppf<0xB1>(x);
  x += dppf<0x4E>(x);
  x += dppf<0x141>(x);
  x += dppf<0x140>(x);
  return x;
}

DI void tconv_tile(const float* __restrict__ src, int C, int Cv, bf16_t* __restrict__ dst, int ldd, int r0, int c0, float* tile) {
  const int tid = threadIdx.x;
  {
    const int tx = tid & 63, ty = tid >> 6;
#pragma unroll
    for (int i = 0; i < 8; ++i) {
      const int r = ty + 8 * i;
      const int c = c0 + tx;
      tile[r * 65 + tx] = (c < Cv) ? src[(size_t)(r0 + r) * C + c] : 0.f;
    }
  }
  __syncthreads();
  {
    const int rr = 2 * (tid & 31), cb = tid >> 5;
#pragma unroll
    for (int i = 0; i < 4; ++i) {
      const int cc = cb + 16 * i;
      const unsigned v = pk2(tile[rr * 65 + cc], tile[(rr + 1) * 65 + cc]);
      *(unsigned*)(dst + (size_t)(c0 + cc) * ldd + r0 + rr) = v;
    }
  }
  __syncthreads();
}

__global__ __launch_bounds__(NTH) void k_tconv(const float* src, int R, int C, int Cv, int Cpad, bf16_t* dst, int ldd, int zdiv,
                                               long s_hi, long s_lo, long d_hi, long d_lo) {
  __shared__ float tile[64 * 65];
  const int z = blockIdx.z;
  const float* s = src + (z / zdiv) * s_hi + (z % zdiv) * s_lo;
  bf16_t* d = dst + (z / zdiv) * d_hi + (z % zdiv) * d_lo;
  const int nct = Cpad / 64, nrt = R / 64;
  for (int it = blockIdx.x; it < nct * nrt; it += gridDim.x) tconv_tile(s, C, Cv, d, ldd, (it / nct) * 64, (it % nct) * 64, tile);
}

__global__ __launch_bounds__(NTH) void k_lorab(P p) {
  const size_t total = (size_t)DEPTH * 2 * 1024 * 256;
  for (size_t i = (size_t)blockIdx.x * NTH + threadIdx.x; i < total; i += (size_t)gridDim.x * NTH) {
    const int k = i & 255, n = (i >> 8) & 1023, le = (int)(i >> 18);
    float v = 0.f;
    if (n < 512) { if (k < 96) v = p.w_lora_b[((size_t)le * 96 + k) * 512 + n]; }
    else { if (k >= 128 && k < 224) v = p.a_lora_b[((size_t)le * 96 + (k - 128)) * 512 + (n - 512)]; }
    p.WtLb[i] = f2bf(v);
  }
}

template <bool F32OUT> DI void rms_phase(const float* __restrict__ x, const float* __restrict__ g, bf16_t* hb, float* ho, int bid, int nblk) {
  const int wave = threadIdx.x >> 6, lane = threadIdx.x & 63;
  for (int t = bid * 8 + wave; t < T; t += nblk * 8) {
    const f32x4* xr = (const f32x4*)(x + (size_t)t * DM);
    f32x4 v[8];
    float s = 0.f;
#pragma unroll
    for (int j = 0; j < 8; ++j) { v[j] = xr[lane + 64 * j]; s += v[j].x * v[j].x + v[j].y * v[j].y + v[j].z * v[j].z + v[j].w * v[j].w; }
    s = wave_sum(s);
    const float rstd = rsqrtf(s * (1.f / DM) + 1e-6f);
#pragma unroll
    for (int j = 0; j < 8; ++j) {
      const f32x4 gg = ((const f32x4*)g)[lane + 64 * j];
      f32x4 o = v[j] * rstd * gg;
      if (F32OUT) ((f32x4*)(ho + (size_t)t * DM))[lane + 64 * j] = o;
      else { u32x2 pk = {pk2(o.x, o.y), pk2(o.z, o.w)}; ((u32x2*)(hb + (size_t)t * DM))[lane + 64 * j] = pk; }
    }
  }
}
__global__ __launch_bounds__(NTH) void k_rms(const float* x, const float* g, bf16_t* hb) { rms_phase<false>(x, g, hb, nullptr, blockIdx.x, gridDim.x); }
__global__ __launch_bounds__(NTH) void k_rms_final(const float* x, const float* g, float* o) { rms_phase<true>(x, g, nullptr, o, blockIdx.x, gridDim.x); }

constexpr int BM = 256, BK = 64, HALF = 128, HT = HALF * BK, GEMM_LDS = 8 * HT * 2, NXCD = 8, WGM = 8;
DI int lds_byte(int r, int c) {
  int st = (r >> 4) * 2 + (c >> 5), rr = r & 15, cc = c & 31, ob = rr * 64 + cc * 2;
  return st * 1024 + (ob ^ (((ob >> 9) & 1) << 5));
}
DI void stage_rc(int b, int& R, int& C) {
  int st = b / 1024, sb = b % 1024, swz = sb ^ (((sb >> 9) & 1) << 5);
  R = (st >> 1) * 16 + swz / 64;
  C = (st & 1) * 32 + (swz % 64) / 2;
}
DI bool gemm_unit(int L, int nM, int nN, int& pm, int& pn) {
  const int nwg = nM * nN;
  if (L >= nwg) return false;
  int wgid = L;
  { const int q = nwg / NXCD, r = nwg % NXCD, xcd = wgid % NXCD, off = wgid / NXCD; wgid = (xcd < r ? xcd * (q + 1) : r * (q + 1) + (xcd - r) * q) + off; }
  const int nig = WGM * nN, gid = wgid / nig, fm = gid * WGM, gsz = (nM - fm) < WGM ? (nM - fm) : WGM;
  pm = fm + ((wgid % nig) % gsz);
  pn = (wgid % nig) / gsz;
  return true;
}

#define LAS __attribute__((address_space(3)))
template <class Epi>
DI void gemm_phase(LAS unsigned char* lds, const bf16_t* Ag, int lda, const bf16_t* Bg, int ldb, int M, int N, int K, const Epi& E, int bid, int nblk) {
  const int tid = threadIdx.x, wid = __builtin_amdgcn_readfirstlane(tid >> 6), lane = tid & 63, wr = wid >> 2, wc = wid & 3, fr = lane & 15, fq = lane >> 4;
  const int nt = K / BK, nM = M / BM, nN = N / BM;
  unsigned voffA[2], voffB[2];
#pragma unroll
  for (int i = 0; i < 2; ++i) { int R, C; stage_rc(tid * 16 + i * 8192, R, C); voffA[i] = (unsigned)(R * lda + C) * 2u; voffB[i] = (unsigned)(R * ldb + C) * 2u; }
  const size_t kstep = (size_t)(BK * 2);
  const size_t hstepA = (size_t)HALF * lda * 2, hstepB = (size_t)HALF * ldb * 2, tstepA = 2 * hstepA, tstepB = 2 * hstepB;
  const unsigned ldsw = (unsigned)wid * 1024u;
  const int aoff = lds_byte(wr * 64 + fr, fq * 8), boff = lds_byte(wc * 32 + fr, fq * 8);
#define G_SA(b, h) (((b) * 2 + (h)) * (HT * 2))
#define G_SB(b, h) ((4 + (b) * 2 + (h)) * (HT * 2))
#define G_STAGE(bufoff, gbase, voff) do { _Pragma("unroll") for (int _i = 0; _i < 2; ++_i) \
    __builtin_amdgcn_global_load_lds((const unsigned*)((const char*)(gbase) + (voff)[_i]), (LAS unsigned*)(lds + (bufoff) + ldsw + _i * 8192), 16, 0, 0); } while (0)
#define G_LDA(dst, b, h) do { _Pragma("unroll") for (int m = 0; m < 4; ++m) _Pragma("unroll") for (int k = 0; k < 2; ++k) dst[m][k] = *(const LAS bf16x8*)(lds + G_SA(b, h) + aoff + m * 2048 + k * 1024); } while (0)
#define G_LDB(dst, b, h) do { _Pragma("unroll") for (int n = 0; n < 2; ++n) _Pragma("unroll") for (int k = 0; k < 2; ++k) dst[n][k] = *(const LAS bf16x8*)(lds + G_SB(b, h) + boff + n * 2048 + k * 1024); } while (0)
#define G_MMA(ai, bj, At_, Bt_) do { __builtin_amdgcn_s_setprio(1); _Pragma("unroll") for (int m = 0; m < 4; ++m) _Pragma("unroll") for (int n = 0; n < 2; ++n) _Pragma("unroll") for (int k = 0; k < 2; ++k) \
    acc[ai][bj][m][n] = __builtin_amdgcn_mfma_f32_16x16x32_bf16(Bt_[n][k], At_[m][k], acc[ai][bj][m][n], 0, 0, 0); __builtin_amdgcn_s_setprio(0); } while (0)
#define G_WAIT_V(n) asm volatile("s_waitcnt vmcnt(" #n ")" ::: "memory")
#define G_WAIT_L(n) asm volatile("s_waitcnt lgkmcnt(" #n ")" ::: "memory")
#define G_BAR __builtin_amdgcn_s_barrier()
#define G_SCHED __builtin_amdgcn_sched_barrier(0)
  int pm, pn, npm = 0, npn = 0, ui = 0;
  if (!gemm_unit(bid, nM, nN, pm, pn)) return;
  f32x4 acc[2][2][4][2];
#pragma unroll
  for (int a = 0; a < 2; ++a)
#pragma unroll
    for (int b = 0; b < 2; ++b)
#pragma unroll
      for (int m = 0; m < 4; ++m)
#pragma unroll
        for (int n = 0; n < 2; ++n) acc[a][b][m][n] = (f32x4){0.f, 0.f, 0.f, 0.f};
  bf16x8 At[4][2], B0[2][2], B1[2][2];
  const char* cA = (const char*)Ag + (size_t)pm * tstepA;
  const char* cB = (const char*)Bg + (size_t)pn * tstepB;
  G_STAGE(G_SB(0, 0), cB, voffB); G_STAGE(G_SA(0, 0), cA, voffA); G_STAGE(G_SB(0, 1), cB + hstepB, voffB); G_STAGE(G_SA(0, 1), cA + hstepA, voffA);
  if (wr == 1) G_BAR;
  G_WAIT_V(4); G_BAR;
  G_STAGE(G_SB(1, 0), cB + kstep, voffB); G_STAGE(G_SA(1, 0), cA + kstep, voffA); G_STAGE(G_SB(1, 1), cB + hstepB + kstep, voffB);
  G_WAIT_V(6); G_BAR;
  for (;;) {
    const bool has_next = gemm_unit(bid + (ui + 1) * nblk, nM, nN, npm, npn);
    const char* nA = has_next ? (const char*)Ag + (size_t)npm * tstepA : cA;
    const char* nB = has_next ? (const char*)Bg + (size_t)npn * tstepB : cB;
#pragma unroll 1
    for (int t = 0; t < nt; t += 2) {
      const bool last = (t == nt - 2);
      const char* a1 = cA + (size_t)(t + 1) * kstep;
      const char* a2 = last ? nA : cA + (size_t)(t + 2) * kstep;
      const char* b2 = last ? nB : cB + (size_t)(t + 2) * kstep;
      const char* a3 = a2 + kstep;
      const char* b3 = b2 + kstep;
      G_LDB(B0, 0, 0); G_SCHED; G_LDA(At, 0, 0); G_STAGE(G_SA(1, 1), a1 + hstepA, voffA);
      G_WAIT_L(8); G_BAR; G_WAIT_L(0); G_MMA(0, 0, At, B0); G_BAR; G_SCHED;
      G_LDB(B1, 0, 1); G_STAGE(G_SB(0, 0), b2, voffB);
      G_BAR; G_WAIT_L(0); G_MMA(0, 1, At, B1); G_BAR;
      G_LDA(At, 0, 1); G_STAGE(G_SA(0, 0), a2, voffA);
      G_BAR; G_WAIT_L(0); G_MMA(1, 0, At, B0); G_BAR; G_SCHED;
      G_STAGE(G_SB(0, 1), b2 + hstepB, voffB);
      G_WAIT_V(6); G_BAR; G_MMA(1, 1, At, B1); G_BAR;
      G_LDB(B0, 1, 0); G_SCHED; G_LDA(At, 1, 0); G_STAGE(G_SA(0, 1), a2 + hstepA, voffA);
      G_WAIT_L(8); G_BAR; G_WAIT_L(0); G_MMA(0, 0, At, B0); G_BAR; G_SCHED;
      G_LDB(B1, 1, 1); G_STAGE(G_SB(1, 0), b3, voffB);
      G_BAR; G_WAIT_L(0); G_MMA(0, 1, At, B1); G_BAR;
      G_LDA(At, 1, 1); G_STAGE(G_SA(1, 0), a3, voffA);
      G_BAR; G_WAIT_L(0); G_MMA(1, 0, At, B0); G_BAR; G_SCHED;
      G_STAGE(G_SB(1, 1), b3 + hstepB, voffB);
      G_WAIT_V(6); G_BAR; G_MMA(1, 1, At, B1); G_BAR;
    }
    E(acc, pm * BM, pn * BM, wr, wc, fr, fq);
    if (!has_next) break;
#pragma unroll
    for (int a = 0; a < 2; ++a)
#pragma unroll
      for (int b = 0; b < 2; ++b)
#pragma unroll
        for (int m = 0; m < 4; ++m)
#pragma unroll
          for (int n = 0; n < 2; ++n) acc[a][b][m][n] = (f32x4){0.f, 0.f, 0.f, 0.f};
    pm = npm; pn = npn; cA = nA; cB = nB; ++ui;
  }
  G_WAIT_V(0);
  if (wr == 0) G_BAR;
  G_BAR;
#undef G_SA
#undef G_SB
#undef G_STAGE
#undef G_LDA
#undef G_LDB
#undef G_MMA
}

struct EpiProj {
  bf16_t* proj;
  DI void operator()(const f32x4 (&acc)[2][2][4][2], int brow, int bcol, int wr, int wc, int fr, int fq) const {
#pragma unroll
    for (int ai = 0; ai < 2; ++ai)
#pragma unroll
      for (int m = 0; m < 4; ++m) {
        const int row = brow + ai * 128 + wr * 64 + m * 16 + fr;
#pragma unroll
        for (int bj = 0; bj < 2; ++bj)
#pragma unroll
          for (int n = 0; n < 2; ++n) {
            const int col = bcol + bj * 128 + wc * 32 + n * 16 + fq * 4;
            f32x4 v = acc[ai][bj][m][n];
            if (bcol >= PIN && bj == 0) { v.x = tanhf(v.x); v.y = tanhf(v.y); v.z = tanhf(v.z); v.w = tanhf(v.w); }
            u32x2 pk = {pk2(v.x, v.y), pk2(v.z, v.w)};
            *(u32x2*)(proj + (size_t)row * NP + col) = pk;
          }
      }
  }
};
struct EpiLora {
  float* lw; const float* w0; const float* a0;
  DI void operator()(const f32x4 (&acc)[2][2][4][2], int brow, int bcol, int wr, int wc, int fr, int fq) const {
#pragma unroll
    for (int ai = 0; ai < 2; ++ai)
#pragma unroll
      for (int m = 0; m < 4; ++m) {
        const int row = brow + ai * 128 + wr * 64 + m * 16 + fr;
#pragma unroll
        for (int bj = 0; bj < 2; ++bj)
#pragma unroll
          for (int n = 0; n < 2; ++n) {
            const int col = bcol + bj * 128 + wc * 32 + n * 16 + fq * 4;
            f32x4 v = acc[ai][bj][m][n], o;
            if (col < 512) {
              const f32x4 b = *(const f32x4*)(w0 + col);
#pragma unroll
              for (int j = 0; j < 4; ++j) { const float wl = v[j] + b[j]; o[j] = __expf(-sigmoidf_(wl) * 0.60653066f); }
            } else {
              const f32x4 b = *(const f32x4*)(a0 + col - 512);
#pragma unroll
              for (int j = 0; j < 4; ++j) o[j] = sigmoidf_(v[j] + b[j]);
            }
            *(f32x4*)(lw + (size_t)row * 1024 + col) = o;
          }
      }
  }
};
struct EpiBranch {
  const bf16_t* proj; const float* bg; float* mf; bf16_t* mb; int kb;
  DI void operator()(const f32x4 (&acc)[2][2][4][2], int brow, int bcol, int wr, int wc, int fr, int fq) const {
#pragma unroll
    for (int ai = 0; ai < 2; ++ai)
#pragma unroll
      for (int m = 0; m < 4; ++m) {
        const int row = brow + ai * 128 + wr * 64 + m * 16 + fr;
#pragma unroll
        for (int bj = 0; bj < 2; ++bj)
#pragma unroll
          for (int n = 0; n < 2; ++n) {
            const int col = bcol + bj * 128 + wc * 32 + n * 16 + fq * 4;
            const f32x4 v = acc[ai][bj][m][n];
            const u32x2 gp = *(const u32x2*)(proj + (size_t)row * NP + C_GATE + kb * DM + col);
            const f32x4 b = *(const f32x4*)(bg + col);
            f32x4 o;
            o.x = sigmoidf_(__uint_as_float(gp.x << 16) + b.x) * v.x;
            o.y = sigmoidf_(__uint_as_float(gp.x & 0xffff0000u) + b.y) * v.y;
            o.z = sigmoidf_(__uint_as_float(gp.y << 16) + b.z) * v.z;
            o.w = sigmoidf_(__uint_as_float(gp.y & 0xffff0000u) + b.w) * v.w;
            float* mp = mf + (size_t)row * DM + col;
            if (kb > 0) o += *(const f32x4*)mp;
            if (kb < 3) *(f32x4*)mp = o;
            else { u32x2 pk = {pk2(o.x, o.y), pk2(o.z, o.w)}; *(u32x2*)(mb + (size_t)row * DM + col) = pk; }
          }
      }
  }
};
struct EpiOut {
  const float* xin; float* xout;
  DI void operator()(const f32x4 (&acc)[2][2][4][2], int brow, int bcol, int wr, int wc, int fr, int fq) const {
#pragma unroll
    for (int ai = 0; ai < 2; ++ai)
#pragma unroll
      for (int m = 0; m < 4; ++m) {
        const int row = brow + ai * 128 + wr * 64 + m * 16 + fr;
#pragma unroll
        for (int bj = 0; bj < 2; ++bj)
#pragma unroll
          for (int n = 0; n < 2; ++n) {
            const int col = bcol + bj * 128 + wc * 32 + n * 16 + fq * 4;
            const size_t o = (size_t)row * DM + col;
            *(f32x4*)(xout + o) = *(const f32x4*)(xin + o) + acc[ai][bj][m][n];
          }
      }
  }
};

__global__ __launch_bounds__(NTH) void k_gemm_in(P p, int l) {
  extern __shared__ __attribute__((aligned(16))) unsigned char shm[];
  EpiProj e{p.proj};
  gemm_phase((LAS unsigned char*)shm, p.h, DM, p.WtIn + (size_t)l * NP * DM, DM, T, NP, DM, e, blockIdx.x, gridDim.x);
}
__global__ __launch_bounds__(NTH) void k_gemm_lora(P p, int l) {
  extern __shared__ __attribute__((aligned(16))) unsigned char shm[];
  const int e = blockIdx.y;
  EpiLora ep{p.lw + (size_t)e * T * 1024, p.w0 + (size_t)(l * 2 + e) * 512, p.a0 + (size_t)(l * 2 + e) * 512};
  gemm_phase((LAS unsigned char*)shm, p.proj + PIN + e * 256, NP, p.WtLb + (size_t)(l * 2 + e) * 1024 * 256, 256, T, 1024, 256, ep, blockIdx.x, gridDim.x);
}
__global__ __launch_bounds__(NTH) void k_gemm_branch(P p, int l, int kb) {
  extern __shared__ __attribute__((aligned(16))) unsigned char shm[];
  EpiBranch e{p.proj, p.b_gate + (size_t)(l * 4 + kb) * DM, p.mergedf, p.mergedb, kb};
  gemm_phase((LAS unsigned char*)shm, p.ys + kb * BW, DM, p.WtBr + (size_t)(l * 4 + kb) * DM * BW, BW, T, DM, BW, e, blockIdx.x, gridDim.x);
}
__global__ __launch_bounds__(NTH) void k_gemm_out(P p, int l, const float* xin, float* xout) {
  extern __shared__ __attribute__((aligned(16))) unsigned char shm[];
  EpiOut e{xin, xout};
  gemm_phase((LAS unsigned char*)shm, p.mergedb, DM, p.WtOut + (size_t)l * DM * DM, DM, T, DM, DM, e, blockIdx.x, gridDim.x);
}

DI float ldp(const bf16_t* proj, int t, int col) { return bf2f(proj[(size_t)t * NP + col]); }

DI void prep_ad_phase(const P& p, int l, int bid, int nblk) {
  const float* cw = p.conv_a_w + (size_t)l * 3 * BW;
  for (size_t i = (size_t)bid * NTH + threadIdx.x; i < (size_t)T * BW; i += (size_t)nblk * NTH) {
    const int c = i & 511, t = (int)(i >> 9), s = t & (SEQ - 1);
    const float u0 = ldp(p.proj, t, C_ACG + c) * ldp(p.proj, t, C_AX + c);
    const float um = (s > 0) ? ldp(p.proj, t - 1, C_ACG + c) * ldp(p.proj, t - 1, C_AX + c) : 0.f;
    const float up = (s < SEQ - 1) ? ldp(p.proj, t + 1, C_ACG + c) * ldp(p.proj, t + 1, C_AX + c) : 0.f;
    const float conv = cw[c] * um + cw[BW + c] * u0 + cw[2 * BW + c] * up;
    const float ya = ldp(p.proj, t, C_ABG + c) * conv * siluf_(ldp(p.proj, t, C_AZ + c));
    p.ys[(size_t)t * DM + c] = f2bf(ya);
    p.ubuf[i] = ldp(p.proj, t, C_DV + c) * sigmoidf_(ldp(p.proj, t, C_DG + c));
  }
}

DI void prep_qkv_phase(const P& p, int l, int bid, int nblk) {
  const int wave = threadIdx.x >> 6, lane = threadIdx.x & 63;
  const float gq = p.q_norm_g[l * 64 + lane], gk = p.k_norm_g[l * 64 + lane];
  const int pidx = lane & 15;
  const float inv = exp2f(-(float)pidx * (13.287712379549449f / 16.f));
  for (int w = bid * 8 + wave; w < T * 12; w += nblk * 8) {
    const int t = w / 12, slot = w % 12, s = t & (SEQ - 1), b = t / SEQ;
    if (slot >= 10) {
      const int kvh = slot - 10;
      p.vT[((size_t)(b * 2 + kvh) * 64 + lane) * SEQ + s] = p.proj[(size_t)t * NP + C_V + kvh * 64 + lane];
      continue;
    }
    const int col = (slot < 8) ? (C_Q + slot * 64) : (C_K + (slot - 8) * 64);
    const float xv = ldp(p.proj, t, col + lane);
    const float ss = wave_sum(xv * xv);
    const float xn = xv * rsqrtf(ss * (1.f / 64.f) + 1e-6f) * ((slot < 8) ? gq : gk);
    const float pos = (lane < 32) ? (float)(s >> 6) : (float)(s & 63);
    const float ang = pos * inv;
    float sn, cs;
    sincosf(ang, &sn, &cs);
    const float other = __shfl_xor(xn, 16);
    const float o = ((lane & 16) == 0) ? (xn * cs - other * sn) : (xn * cs + other * sn);
    if (slot < 8) p.qn[(size_t)t * 512 + slot * 64 + lane] = f2bf(o);
    else p.kn[(size_t)t * 128 + (slot - 8) * 64 + lane] = f2bf(o);
  }
}

DI void prep_rwkv_phase(const P& p, int l, int bid, int nblk) {
  const int wave = threadIdx.x >> 6, lane = threadIdx.x & 63;
  for (int w = bid * 8 + wave; w < 2 * T * 8; w += nblk * 8) {
    const int h = w & 7, t = (w >> 3) & (T - 1), e = w >> 16;
    const int s = t & (SEQ - 1), b = t / SEQ, c = h * 64 + lane;
    const bool valid = e ? (s < SEQ - 1) : (s > 0);
    const int tp = e ? t + 1 : t - 1;
    const float* mu = p.mu_rkv + (size_t)(l * 2 + e) * 3 * BW;
    const float rc = ldp(p.proj, t, C_CR + c), kc = ldp(p.proj, t, C_CK + c), vc = ldp(p.proj, t, C_CV + c);
    const float rp = valid ? ldp(p.proj, tp, C_CR + c) : 0.f, kp = valid ? ldp(p.proj, tp, C_CK + c) : 0.f, vp = valid ? ldp(p.proj, tp, C_CV + c) : 0.f;
    const float r2 = rc + (rp - rc) * mu[c], k2 = kc + (kp - kc) * mu[BW + c], v2 = vc + (vp - vc) * mu[2 * BW + c];
    const float dec = p.lw[((size_t)e * T + t) * 1024 + c], a = p.lw[((size_t)e * T + t) * 1024 + 512 + c];
    float kk = k2 * p.k_k[l * BW + c];
    const float nrm = sqrtf(wave_sum(kk * kk));
    kk = kk / fmaxf(nrm, 1e-12f);
    const float kt = k2 * (1.f + (a - 1.f) * p.k_a[l * BW + c]);
    const float bonus = wave_sum(r2 * kt * p.r_k[l * BW + c]);
    p.bonusv[((size_t)e * T + t) * BW + c] = bonus * v2;
    const int j = e ? (SEQ - 1 - s) : s;
    float* si = p.SI + (((size_t)((e * 2 + b) * 8 + h)) * SEQ + j) * 384;
    si[lane] = r2; si[64 + lane] = dec; si[128 + lane] = kt; si[192 + lane] = -kk; si[256 + lane] = kk * a; si[320 + lane] = v2;
  }
}
__global__ __launch_bounds__(NTH) void k_prep1(P p, int l) { prep_ad_phase(p, l, blockIdx.x, gridDim.x); prep_qkv_phase(p, l, blockIdx.x, gridDim.x); }
__global__ __launch_bounds__(NTH) void k_prep2(P p, int l) { prep_rwkv_phase(p, l, blockIdx.x, gridDim.x); }

DI void convd_phase(const P& p, int l, float* red, int bid, int nblk) {
  const int c = threadIdx.x, wave = c >> 6, lane = c & 63;
  const float* dw = p.dw_w + (size_t)l * 31 * BW;
  float wreg[31];
#pragma unroll
  for (int j = 0; j < 31; ++j) wreg[j] = dw[j * BW + c];
  const float bias = p.dw_b[l * BW + c], lg = p.ln_g[l * BW + c], lb = p.ln_b[l * BW + c];
  for (int t = bid; t < T; t += nblk) {
    const int s = t & (SEQ - 1);
    float acc = bias;
#pragma unroll
    for (int j = 0; j < 31; ++j) {
      const int sj = s + j - 15;
      if (sj >= 0 && sj < SEQ) acc += wreg[j] * p.ubuf[(size_t)(t + j - 15) * BW + c];
    }
    float sm = wave_sum(acc);
    __syncthreads();
    if (lane == 0) red[wave] = sm;
    __syncthreads();
    float tot = 0.f;
#pragma unroll
    for (int i = 0; i < 8; ++i) tot += red[i];
    const float mean = tot * (1.f / BW);
    const float d = acc - mean;
    float sv = wave_sum(d * d);
    __syncthreads();
    if (lane == 0) red[wave] = sv;
    __syncthreads();
    float tv = 0.f;
#pragma unroll
    for (int i = 0; i < 8; ++i) tv += red[i];
    const float un = d * rsqrtf(tv * (1.f / BW) + 1e-5f) * lg + lb;
    const float yd = siluf_(un) * siluf_(ldp(p.proj, t, C_DZ + c));
    p.ys[(size_t)t * DM + 3 * BW + c] = f2bf(yd);
  }
}
__global__ __launch_bounds__(NTH) void k_convd(P p, int l) { __shared__ float red[8]; convd_phase(p, l, red, blockIdx.x, gridDim.x); }

#define MFMA32(a, b, c) __builtin_amdgcn_mfma_f32_32x32x16_bf16((a), (b), (c), 0, 0, 0)
DI void attn_phase(const P& p, int l, char* smem, int bid, int nblk) {
  const int tid = threadIdx.x, wave = tid >> 6, lane = tid & 63, r = lane & 31, hh = lane >> 5;
  const float gq = wave_max(fabsf(p.q_norm_g[l * 64 + lane])), gk = wave_max(fabsf(p.k_norm_g[l * 64 + lane]));
  const float Mb = 8.f * gq * gk * 1.0001f;
  const float c1 = 0.125f * 1.44269504f, c2 = Mb * 1.44269504f;
  const int row = tid >> 3, c16 = tid & 7;
  const int woff = row * 128 + ((c16 ^ ((row >> 1) & 7)) << 4);
  for (int item = bid; item < 256; item += nblk) {
    const int b = item >> 7, head = (item >> 4) & 7, qt = item & 15, kvh = head >> 2;
    const int t0 = b * SEQ + qt * 256 + wave * 32;
    bf16x8 qf[4];
#pragma unroll
    for (int s = 0; s < 4; ++s) qf[s] = *(const bf16x8*)(p.qn + (size_t)(t0 + r) * 512 + head * 64 + 16 * s + 8 * hh);
    f32x16 o0, o1;
#pragma unroll
    for (int i = 0; i < 16; ++i) { o0[i] = 0.f; o1[i] = 0.f; }
    float lsum = 0.f;
    const bf16_t* kbase = p.kn + (size_t)(b * SEQ) * 128 + kvh * 64;
    const bf16_t* vbase = p.vT + (size_t)((b * 2 + kvh) * 64) * SEQ;
    u32x4 kreg = *(const u32x4*)(kbase + (size_t)row * 128 + c16 * 8);
    u32x4 vreg = *(const u32x4*)(vbase + (size_t)row * SEQ + c16 * 8);
    __syncthreads();
    *(u32x4*)(smem + woff) = kreg;
    *(u32x4*)(smem + 16384 + woff) = vreg;
    __syncthreads();
#pragma unroll 1
    for (int kt = 0; kt < 64; ++kt) {
      const int cur = kt & 1;
      if (kt + 1 < 64) {
        kreg = *(const u32x4*)(kbase + (size_t)((kt + 1) * 64 + row) * 128 + c16 * 8);
        vreg = *(const u32x4*)(vbase + (size_t)row * SEQ + (kt + 1) * 64 + c16 * 8);
      }
      const char* kb_ = smem + cur * 8192;
      const char* vb_ = smem + 16384 + cur * 8192;
#pragma unroll
      for (int kb = 0; kb < 2; ++kb) {
        f32x16 sacc;
#pragma unroll
        for (int i = 0; i < 16; ++i) sacc[i] = 0.f;
        const int krow_ = kb * 32 + r;
#pragma unroll
        for (int s = 0; s < 4; ++s) {
          const int c = 2 * s + hh;
          const bf16x8 kf = *(const bf16x8*)(kb_ + krow_ * 128 + ((c ^ ((krow_ >> 1) & 7)) << 4));
          sacc = MFMA32(kf, qf[s], sacc);
        }
        float pv[16];
#pragma unroll
        for (int i = 0; i < 16; ++i) { pv[i] = __builtin_amdgcn_exp2f(sacc[i] * c1 - c2); lsum += pv[i]; }
#pragma unroll
        for (int s2 = 0; s2 < 2; ++s2) {
          u32x4 pp = {pk2(pv[8 * s2], pv[8 * s2 + 1]), pk2(pv[8 * s2 + 2], pv[8 * s2 + 3]), pk2(pv[8 * s2 + 4], pv[8 * s2 + 5]), pk2(pv[8 * s2 + 6], pv[8 * s2 + 7])};
          const bf16x8 pf = __builtin_bit_cast(bf16x8, pp);
          const int cA = kb * 4 + 2 * s2;
#pragma unroll
          for (int dblk = 0; dblk < 2; ++dblk) {
            const int drow = dblk * 32 + r;
            const int sw = (drow >> 1) & 7;
            const u32x2 lo = *(const u32x2*)(vb_ + drow * 128 + ((cA ^ sw) << 4) + 8 * hh);
            const u32x2 hi = *(const u32x2*)(vb_ + drow * 128 + (((cA + 1) ^ sw) << 4) + 8 * hh);
            u32x4 vv = {lo.x, lo.y, hi.x, hi.y};
            const bf16x8 vf = __builtin_bit_cast(bf16x8, vv);
            if (dblk == 0) o0 = MFMA32(vf, pf, o0); else o1 = MFMA32(vf, pf, o1);
          }
        }
      }
      if (kt + 1 < 64) {
        *(u32x4*)(smem + (cur ^ 1) * 8192 + woff) = kreg;
        *(u32x4*)(smem + 16384 + (cur ^ 1) * 8192 + woff) = vreg;
      }
      __syncthreads();
    }
    const float ltot = lsum + __shfl_xor(lsum, 32);
    const float linv = 1.f / ltot;
    const int t = t0 + r;
#pragma unroll
    for (int dblk = 0; dblk < 2; ++dblk)
#pragma unroll
      for (int g = 0; g < 4; ++g) {
        const int d0 = dblk * 32 + 8 * g + 4 * hh;
        const u32x2 zp = *(const u32x2*)(p.proj + (size_t)t * NP + C_BZ + head * 64 + d0);
        float z[4] = {__uint_as_float(zp.x << 16), __uint_as_float(zp.x & 0xffff0000u), __uint_as_float(zp.y << 16), __uint_as_float(zp.y & 0xffff0000u)};
        float ov[4];
#pragma unroll
        for (int j = 0; j < 4; ++j) ov[j] = ((dblk == 0) ? o0[4 * g + j] : o1[4 * g + j]) * linv * siluf_(z[j]);
        u32x2 pk = {pk2(ov[0], ov[1]), pk2(ov[2], ov[3])};
        *(u32x2*)(p.ys + (size_t)t * DM + BW + head * 64 + d0) = pk;
      }
  }
}
__global__ __launch_bounds__(NTH) void k_attn(P p, int l) {
  extern __shared__ __attribute__((aligned(16))) char smem_a[];
  attn_phase(p, l, smem_a, blockIdx.x, gridDim.x);
}

DI void scan_item(const P& p, char* smem, int item) {
  const int tid = threadIdx.x, wave = tid >> 6, lane = tid & 63, kq = lane & 15, rw = lane >> 4;
  const int chain = item >> 1, half = item & 1;
  const int e = chain >> 4, b = (chain >> 3) & 1, h = chain & 7;
  const int v = half * 32 + wave * 4 + rw;
  const float* si = p.SI + (size_t)chain * SEQ * 384;
  float s0 = 0.f, s1 = 0.f, s2 = 0.f, s3 = 0.f;
  constexpr int CH = 32, NCH = SEQ / CH;
  f32x4 pre[6];
#pragma unroll
  for (int i = 0; i < 6; ++i) pre[i] = ((const f32x4*)si)[tid + 512 * i];
  __syncthreads();
#pragma unroll
  for (int i = 0; i < 6; ++i) ((f32x4*)smem)[tid + 512 * i] = pre[i];
  __syncthreads();
  float* yout = p.yraw + ((size_t)e * T + (size_t)b * SEQ) * BW + h * 64 + v;
#pragma unroll 1
  for (int c = 0; c < NCH; ++c) {
    const int cur = c & 1;
    if (c + 1 < NCH) {
#pragma unroll
      for (int i = 0; i < 6; ++i) pre[i] = ((const f32x4*)(si + (size_t)(c + 1) * CH * 384))[tid + 512 * i];
    }
    const float* sb = (const float*)(smem + cur * 49152);
#pragma unroll 4
    for (int jj = 0; jj < CH; ++jj) {
      const float* st = sb + jj * 384;
      const f32x4 r4 = *(const f32x4*)(st + kq * 4), w4 = *(const f32x4*)(st + 64 + kq * 4), kt4 = *(const f32x4*)(st + 128 + kq * 4),
                  kn4 = *(const f32x4*)(st + 192 + kq * 4), bb4 = *(const f32x4*)(st + 256 + kq * 4);
      const float vv = st[320 + v];
      float sa = s0 * kn4.x + s1 * kn4.y + s2 * kn4.z + s3 * kn4.w;
      sa = red16(sa);
      s0 = s0 * w4.x + sa * bb4.x + vv * kt4.x;
      s1 = s1 * w4.y + sa * bb4.y + vv * kt4.y;
      s2 = s2 * w4.z + sa * bb4.z + vv * kt4.z;
      s3 = s3 * w4.w + sa * bb4.w + vv * kt4.w;
      float y = s0 * r4.x + s1 * r4.y + s2 * r4.z + s3 * r4.w;
      y = red16(y);
      if (kq == 0) {
        const int j = c * CH + jj;
        const int so = e ? (SEQ - 1 - j) : j;
        yout[(size_t)so * BW] = y;
      }
    }
    if (c + 1 < NCH) {
#pragma unroll
      for (int i = 0; i < 6; ++i) ((f32x4*)(smem + (cur ^ 1) * 49152))[tid + 512 * i] = pre[i];
    }
    __syncthreads();
  }
}
__global__ __launch_bounds__(NTH) void k_scan(P p) {
  extern __shared__ __attribute__((aligned(16))) char smem_s[];
  scan_item(p, smem_s, blockIdx.x);
}

DI void combine_phase(const P& p, int l, int bid, int nblk) {
  const int wave = threadIdx.x >> 6, lane = threadIdx.x & 63;
  for (int w = bid * 8 + wave; w < T * 8; w += nblk * 8) {
    const int h = w & 7, t = w >> 3, c = h * 64 + lane;
    float tot = 0.f;
#pragma unroll
    for (int e = 0; e < 2; ++e) {
      const float y = p.yraw[((size_t)e * T + t) * BW + c];
      const float mean = wave_sum(y) * (1.f / 64.f);
      const float d = y - mean;
      const float var = wave_sum(d * d) * (1.f / 64.f);
      tot += d * rsqrtf(var + 64e-5f) * p.gn_g[l * BW + c] + p.gn_b[l * BW + c] + p.bonusv[((size_t)e * T + t) * BW + c];
    }
    p.ys[(size_t)t * DM + 2 * BW + c] = f2bf(tot * siluf_(ldp(p.proj, t, C_CZ + c)));
  }
}
__global__ __launch_bounds__(NTH) void k_combine(P p, int l) { combine_phase(p, l, blockIdx.x, gridDim.x); }

extern "C" void kernel_launch(void* const* d_in, const int* in_sizes, int n_in, void* d_out, int out_size, void* d_ws, size_t ws_size, hipStream_t stream) {
  P p{};
  const float** ip = (const float**)&p;
  for (int i = 0; i < 26; ++i) ip[i] = (const float*)d_in[i];
  p.out = (float*)d_out;
  char* w = (char*)d_ws;
  size_t off = 0;
  auto take = [&](size_t bytes) { char* r = w + off; off += (bytes + 255) & ~(size_t)255; return r; };
  p.WtIn = (bf16_t*)take((size_t)DEPTH * NP * DM * 2);
  p.WtBr = (bf16_t*)take((size_t)DEPTH * 4 * DM * BW * 2);
  p.WtOut = (bf16_t*)take((size_t)DEPTH * DM * DM * 2);
  p.WtLb = (bf16_t*)take((size_t)DEPTH * 2 * 1024 * 256 * 2);
  p.h = (bf16_t*)take((size_t)T * DM * 2);
  p.proj = (bf16_t*)take((size_t)T * NP * 2);
  p.qn = (bf16_t*)take((size_t)T * 512 * 2);
  p.kn = (bf16_t*)take((size_t)T * 128 * 2);
  p.vT = (bf16_t*)take((size_t)T * 128 * 2);
  p.ys = (bf16_t*)take((size_t)T * DM * 2);
  p.mergedb = (bf16_t*)take((size_t)T * DM * 2);
  p.lw = (float*)take((size_t)2 * T * 1024 * 4);
  p.SI = (float*)take((size_t)32 * SEQ * 384 * 4);
  p.bonusv = (float*)take((size_t)2 * T * BW * 4);
  p.yraw = (float*)take((size_t)2 * T * BW * 4);
  p.ubuf = (float*)take((size_t)T * BW * 4);
  p.mergedf = (float*)take((size_t)T * DM * 4);
  p.xbuf = (float*)take((size_t)T * DM * 4);
  if (off > ws_size) { fprintf(stderr, "workspace too small: need %zu have %zu\n", off, ws_size); return; }

  static bool attr_done = false;
  if (!attr_done) {
    hipFuncSetAttribute((const void*)k_gemm_in, hipFuncAttributeMaxDynamicSharedMemorySize, GEMM_LDS);
    hipFuncSetAttribute((const void*)k_gemm_lora, hipFuncAttributeMaxDynamicSharedMemorySize, GEMM_LDS);
    hipFuncSetAttribute((const void*)k_gemm_branch, hipFuncAttributeMaxDynamicSharedMemorySize, GEMM_LDS);
    hipFuncSetAttribute((const void*)k_gemm_out, hipFuncAttributeMaxDynamicSharedMemorySize, GEMM_LDS);
    hipFuncSetAttribute((const void*)k_scan, hipFuncAttributeMaxDynamicSharedMemorySize, 98304);
    hipFuncSetAttribute((const void*)k_attn, hipFuncAttributeMaxDynamicSharedMemorySize, 32768);
    attr_done = true;
  }
  const int G = 256;
  k_tconv<<<dim3(2048, 1, DEPTH), NTH, 0, stream>>>(p.w_in, DM, PIN, PIN, PIN, p.WtIn, DM, 1, (long)DM * PIN, 0, (long)NP * DM, 0);
  k_tconv<<<dim3(64, 1, DEPTH * 2), NTH, 0, stream>>>(p.w_lora_a, DM, 96, 96, 128, p.WtIn + (size_t)PIN * DM, DM, 2, (long)2 * DM * 96, (long)DM * 96, (long)NP * DM, (long)256 * DM);
  k_tconv<<<dim3(64, 1, DEPTH * 2), NTH, 0, stream>>>(p.a_lora_a, DM, 96, 96, 128, p.WtIn + (size_t)(PIN + 128) * DM, DM, 2, (long)2 * DM * 96, (long)DM * 96, (long)NP * DM, (long)256 * DM);
  k_tconv<<<dim3(1024, 1, DEPTH), NTH, 0, stream>>>(p.w_out, DM, DM, DM, DM, p.WtOut, DM, 1, (long)DM * DM, 0, (long)DM * DM, 0);
  k_tconv<<<dim3(256, 1, DEPTH * 4), NTH, 0, stream>>>(p.w_branch, BW, DM, DM, DM, p.WtBr, BW, 1, (long)BW * DM, 0, (long)DM * BW, 0);
  k_lorab<<<G * 4, NTH, 0, stream>>>(p);
  const float* xin = p.x;
  for (int l = 0; l < DEPTH; ++l) {
    k_rms<<<G, NTH, 0, stream>>>(xin, p.norm_g + (size_t)l * DM, p.h);
    k_gemm_in<<<G, NTH, GEMM_LDS, stream>>>(p, l);
    k_gemm_lora<<<dim3(128, 2), NTH, GEMM_LDS, stream>>>(p, l);
    k_prep1<<<G * 4, NTH, 0, stream>>>(p, l);
    k_prep2<<<G * 4, NTH, 0, stream>>>(p, l);
    k_scan<<<64, NTH, 98304, stream>>>(p);
    k_attn<<<G, NTH, 32768, stream>>>(p, l);
    k_convd<<<G * 4, NTH, 0, stream>>>(p, l);
    k_combine<<<G * 4, NTH, 0, stream>>>(p, l);
    for (int kb = 0; kb < 4; ++kb) k_gemm_branch<<<G, NTH, GEMM_LDS, stream>>>(p, l, kb);
    k_gemm_out<<<G, NTH, GEMM_LDS, stream>>>(p, l, xin, p.xbuf);
    xin = p.xbuf;
  }
  k_rms_final<<<G, NTH, 0, stream>>>(p.xbuf, p.final_norm_g, p.out);
}
```

```cpp
#include <hip/hip_runtime.h>
#include <hip/hip_bf16.h>
#include <stdint.h>
#include <stdio.h>
#include <hip/hip_cooperative_groups.h>
namespace cg = cooperative_groups;

typedef unsigned short bf16_t;
typedef short bf16x8 __attribute__((ext_vector_type(8)));
typedef float f32x4 __attribute__((ext_vector_type(4)));
typedef float f32x16 __attribute__((ext_vector_type(16)));
typedef unsigned u32x4 __attribute__((ext_vector_type(4)));
typedef unsigned u32x2 __attribute__((ext_vector_type(2)));

#define DI __device__ __forceinline__

constexpr int DM = 2048, BATCH = 2, SEQ = 4096, T = BATCH * SEQ, DEPTH = 4, BW = 512;
constexpr int NP = 15616, PIN = 15104;
constexpr int NTH = 512;
constexpr int C_ABG = 0, C_ACG = 512, C_AX = 1024, C_AZ = 1536, C_Q = 2048, C_K = 2560, C_V = 2688, C_BZ = 2816,
              C_CR = 3328, C_CK = 3840, C_CV = 4352, C_CZ = 4864, C_DV = 5376, C_DG = 5888, C_DZ = 6400, C_GATE = 6912;

struct P {
  const float *x, *norm_g, *w_in, *b_gate, *conv_a_w, *q_norm_g, *k_norm_g, *w0, *w_lora_a, *w_lora_b, *a0, *a_lora_a,
      *a_lora_b, *mu_rkv, *k_k, *k_a, *r_k, *gn_g, *gn_b, *dw_w, *dw_b, *ln_g, *ln_b, *w_branch, *w_out, *final_norm_g;
  float* out;
  bf16_t *WtIn, *WtBr, *WtOut, *WtLb, *h, *proj, *qn, *kn, *vT, *ys, *mergedb;
  float *lw, *SI, *bonusv, *yraw, *ubuf, *mergedf, *xbuf;
  float* rope;
  unsigned* bar;
};

typedef const __attribute__((address_space(4))) P* CP;
DI CP launder(CP x) { asm volatile("" : "+s"(x)); return x; }
DI int ltid() { int t = threadIdx.x; asm volatile("" : "+v"(t)); return t; }
DI float bf2f(bf16_t v) { return __uint_as_float(((unsigned)v) << 16); }
DI unsigned pk2(float lo, float hi) {
  typedef __bf16 bf2 __attribute__((ext_vector_type(2)));
  typedef float f2 __attribute__((ext_vector_type(2)));
  f2 v = {lo, hi};
  bf2 r = __builtin_convertvector(v, bf2);
  return __builtin_bit_cast(unsigned, r);
}
DI bf16_t f2bf(float x) { return (bf16_t)(pk2(x, 0.f) & 0xffffu); }
DI float sigmoidf_(float x) { return __builtin_amdgcn_rcpf(1.f + __builtin_amdgcn_exp2f(-1.44269504f * x)); }
DI float tanhf_(float x) { return 1.f - 2.f * __builtin_amdgcn_rcpf(1.f + __builtin_amdgcn_exp2f(2.88539008f * x)); }
DI float siluf_(float x) { return x * sigmoidf_(x); }
DI float wave_sum(float v) {
#pragma unroll
  for (int o = 1; o < 64; o <<= 1) v += __shfl_xor(v, o);
  return v;
}
DI float wave_max(float v) {
#pragma unroll
  for (int o = 1; o < 64; o <<= 1) v = fmaxf(v, __shfl_xor(v, o));
  return v;
}
template <int CTRL> DI float dppf(float x) {
  return __int_as_float(__builtin_amdgcn_update_dpp(0, __float_as_int(x), CTRL, 0xf, 0xf, true));
}
DI float red16(float x) {
  x += dppf<0xB1>(x);
  x += dppf<0x4E>(x);
  x += dppf<0x141>(x);
  x += dppf<0x140>(x);
  return x;
}

DI void tconv_tile(const float* __restrict__ src, int C, int Cv, bf16_t* __restrict__ dst, int ldd, int r0, int c0, float* tile) {
  const int tid = ltid();
  {
    const int tx = tid & 127, ty = tid >> 7;
    const int c = c0 + tx;
    float v[16];
#pragma unroll
    for (int i = 0; i < 16; ++i) v[i] = (c < Cv) ? src[(size_t)(r0 + ty + 4 * i) * C + c] : 0.f;
#pragma unroll
    for (int i = 0; i < 16; ++i) tile[(ty + 4 * i) * 129 + tx] = v[i];
  }
  __syncthreads();
  {
    const int rr = 4 * (tid & 15), cb = tid >> 4;
#pragma unroll
    for (int i = 0; i < 4; ++i) {
      const int cc = cb + 32 * i;
      u32x2 v = {pk2(tile[rr * 129 + cc], tile[(rr + 1) * 129 + cc]), pk2(tile[(rr + 2) * 129 + cc], tile[(rr + 3) * 129 + cc])};
      *(u32x2*)(dst + (size_t)(c0 + cc) * ldd + r0 + rr) = v;
    }
  }
  __syncthreads();
}

constexpr int TC_IN = 118 * 32, TC_LA = 128, TC_OUT = 512, TC_BR = 512, TC_L = TC_IN + TC_LA + TC_OUT + TC_BR, TC_SPLIT = 1728, TC_SPLIT2 = 3840;
DI void tconv_range(CP p, float* tile, int l, int lo, int hi, int bid, int nblk) {
  __syncthreads();
  for (int it = lo + bid; it < hi; it += nblk) {
    int r = it;
    if (r < TC_IN) { tconv_tile(p->w_in + (size_t)l * DM * PIN, PIN, PIN, p->WtIn + (size_t)l * NP * DM, DM, (r / 118) * 64, (r % 118) * 128, tile); continue; }
    r -= TC_IN;
    if (r < TC_LA) {
      const int mtx = r >> 5, tl = r & 31, e = mtx >> 1, isa = mtx & 1;
      const float* src = (isa ? p->a_lora_a : p->w_lora_a) + (size_t)(l * 2 + e) * DM * 96;
      bf16_t* dst = p->WtIn + (size_t)l * NP * DM + (size_t)(PIN + e * 256 + isa * 128) * DM;
      tconv_tile(src, 96, 96, dst, DM, tl * 64, 0, tile);
      continue;
    }
    r -= TC_LA;
    if (r < TC_OUT) { tconv_tile(p->w_out + (size_t)l * DM * DM, DM, DM, p->WtOut + (size_t)l * DM * DM, DM, (r >> 4) * 64, (r & 15) * 128, tile); continue; }
    r -= TC_OUT;
    { const int kb = r >> 7, tl = r & 127;
      tconv_tile(p->w_branch + (size_t)(l * 4 + kb) * BW * DM, DM, DM, p->WtBr + (size_t)(l * 4 + kb) * DM * BW, BW, (tl >> 4) * 64, (tl & 15) * 128, tile); }
  }
}

DI void lorab_phase(CP p, int bid, int nblk) {
  const size_t total = (size_t)DEPTH * 2 * 1024 * 256;
  for (size_t i = (size_t)bid * NTH + ltid(); i < total; i += (size_t)nblk * NTH) {
    const int k = i & 255, n = (i >> 8) & 1023, le = (int)(i >> 18);
    float v = 0.f;
    if (n < 512) { if (k < 96) v = p->w_lora_b[((size_t)le * 96 + k) * 512 + n]; }
    else { if (k >= 128 && k < 224) v = p->a_lora_b[((size_t)le * 96 + (k - 128)) * 512 + (n - 512)]; }
    p->WtLb[i] = f2bf(v);
  }
}

template <bool F32OUT> DI void rms_phase(const float* __restrict__ x, const float* __restrict__ g, bf16_t* hb, float* ho, int bid, int nblk) {
  const int tid_ = ltid(); const int wave = tid_ >> 6, lane = tid_ & 63;
  for (int t = bid * 8 + wave; t < T; t += nblk * 8) {
    const f32x4* xr = (const f32x4*)(x + (size_t)t * DM);
    f32x4 v[8];
    float s = 0.f;
#pragma unroll
    for (int j = 0; j < 8; ++j) { v[j] = xr[lane + 64 * j]; s += v[j].x * v[j].x + v[j].y * v[j].y + v[j].z * v[j].z + v[j].w * v[j].w; }
    s = wave_sum(s);
    const float rstd = rsqrtf(s * (1.f / DM) + 1e-6f);
#pragma unroll
    for (int j = 0; j < 8; ++j) {
      const f32x4 gg = ((const f32x4*)g)[lane + 64 * j];
      f32x4 o = v[j] * rstd * gg;
      if (F32OUT) ((f32x4*)(ho + (size_t)t * DM))[lane + 64 * j] = o;
      else { u32x2 pk = {pk2(o.x, o.y), pk2(o.z, o.w)}; ((u32x2*)(hb + (size_t)t * DM))[lane + 64 * j] = pk; }
    }
  }
}

constexpr int BM = 256, BK = 64, HALF = 128, HT = HALF * BK, GEMM_LDS = 9 * HT * 2, NXCD = 8, WGM = 8;
DI int lds_byte(int r, int c) {
  int st = (r >> 4) * 2 + (c >> 5), rr = r & 15, cc = c & 31, ob = rr * 64 + cc * 2;
  return st * 1024 + (ob ^ (((ob >> 9) & 1) << 5));
}
DI void stage_rc(int b, int& R, int& C) {
  int st = b / 1024, sb = b % 1024, swz = sb ^ (((sb >> 9) & 1) << 5);
  R = (st >> 1) * 16 + swz / 64;
  C = (st & 1) * 32 + (swz % 64) / 2;
}
DI int perm32(int rho) { const int n = rho >> 4, i = rho & 15; return 8 * (i >> 2) + 4 * n + (i & 3); }
DI bool gemm_unit(int L, int nM, int nN, int& pm, int& pn) {
  const int nwg = nM * nN;
  if (L >= nwg) return false;
  int wgid = L;
  { const int q = nwg / NXCD, r = nwg % NXCD, xcd = wgid % NXCD, off = wgid / NXCD; wgid = (xcd < r ? xcd * (q + 1) : r * (q + 1) + (xcd - r) * q) + off; }
  const int nig = WGM * nN, gid = wgid / nig, fm = gid * WGM, gsz = (nM - fm) < WGM ? (nM - fm) : WGM;
  pm = fm + ((wgid % nig) % gsz);
  pn = (wgid % nig) / gsz;
  return true;
}

#define LAS __attribute__((address_space(3)))
template <class Epi>
DI void gemm_phase(LAS unsigned char* lds, const bf16_t* Ag, int lda, const bf16_t* Bg, int ldb, int M, int N, int K, const Epi& E, int bid, int nblk) {
  const int tid = ltid(), wid = __builtin_amdgcn_readfirstlane(tid >> 6), lane = tid & 63, wr = wid >> 2, wc = wid & 3, fr = lane & 15, fq = lane >> 4;
  const int nt = K / BK, nM = M / BM, nN = N / BM;
  unsigned voffA[2], voffB[2];
#pragma unroll
  for (int i = 0; i < 2; ++i) { int R, C; stage_rc(tid * 16 + i * 8192, R, C); const int Rb = Epi::PERM ? ((R & ~31) + perm32(R & 31)) : R; voffA[i] = (unsigned)(R * lda + C) * 2u; voffB[i] = (unsigned)(Rb * ldb + C) * 2u; }
  const size_t kstep = (size_t)(BK * 2);
  const size_t hstepA = (size_t)HALF * lda * 2, hstepB = (size_t)HALF * ldb * 2, tstepA = 2 * hstepA, tstepB = 2 * hstepB;
  const unsigned ldsw = (unsigned)wid * 1024u;
  const int aoff = lds_byte(wr * 64 + fr, fq * 8), boff = lds_byte(wc * 32 + fr, fq * 8);
#define G_SA(b, h) (((b) * 2 + (h)) * (HT * 2))
#define G_SB(b, h) ((4 + (b) * 2 + (h)) * (HT * 2))
#define G_STAGE(bufoff, gbase, voff) do { _Pragma("unroll") for (int _i = 0; _i < 2; ++_i) \
    __builtin_amdgcn_global_load_lds((const unsigned*)((const char*)(gbase) + (voff)[_i]), (LAS unsigned*)(lds + (bufoff) + ldsw + _i * 8192), 16, 0, 0); } while (0)
#define G_LDA(dst, b, h) do { _Pragma("unroll") for (int m = 0; m < 4; ++m) _Pragma("unroll") for (int k = 0; k < 2; ++k) dst[m][k] = *(const LAS bf16x8*)(lds + G_SA(b, h) + aoff + m * 2048 + k * 1024); } while (0)
#define G_LDB(dst, b, h) do { _Pragma("unroll") for (int n = 0; n < 2; ++n) _Pragma("unroll") for (int k = 0; k < 2; ++k) dst[n][k] = *(const LAS bf16x8*)(lds + G_SB(b, h) + boff + n * 2048 + k * 1024); } while (0)
#define G_MMA(ai, bj, At_, Bt_) do { __builtin_amdgcn_s_setprio(1); _Pragma("unroll") for (int m = 0; m < 4; ++m) _Pragma("unroll") for (int n = 0; n < 2; ++n) _Pragma("unroll") for (int k = 0; k < 2; ++k) \
    acc[ai][bj][m][n] = __builtin_amdgcn_mfma_f32_16x16x32_bf16(Bt_[n][k], At_[m][k], acc[ai][bj][m][n], 0, 0, 0); __builtin_amdgcn_s_setprio(0); } while (0)
#define G_WAIT_V(n) asm volatile("s_waitcnt vmcnt(" #n ")" ::: "memory")
#define G_WAIT_L(n) asm volatile("s_waitcnt lgkmcnt(" #n ")" ::: "memory")
#define G_BAR __builtin_amdgcn_s_barrier()
#define G_SCHED __builtin_amdgcn_sched_barrier(0)
  int pm, pn, npm = 0, npn = 0, ui = 0;
  if (!gemm_unit(bid, nM, nN, pm, pn)) return;
  f32x4 acc[2][2][4][2];
#pragma unroll
  for (int a = 0; a < 2; ++a)
#pragma unroll
    for (int b = 0; b < 2; ++b)
#pragma unroll
      for (int m = 0; m < 4; ++m)
#pragma unroll
        for (int n = 0; n < 2; ++n) acc[a][b][m][n] = (f32x4){0.f, 0.f, 0.f, 0.f};
  bf16x8 At[4][2], B0[2][2], B1[2][2];
  const char* cA = (const char*)Ag + (size_t)pm * tstepA;
  const char* cB = (const char*)Bg + (size_t)pn * tstepB;
  G_STAGE(G_SB(0, 0), cB, voffB); G_STAGE(G_SA(0, 0), cA, voffA); G_STAGE(G_SB(0, 1), cB + hstepB, voffB); G_STAGE(G_SA(0, 1), cA + hstepA, voffA);
  if (wr == 1) G_BAR;
  G_WAIT_V(4); G_BAR;
  G_STAGE(G_SB(1, 0), cB + kstep, voffB); G_STAGE(G_SA(1, 0), cA + kstep, voffA); G_STAGE(G_SB(1, 1), cB + hstepB + kstep, voffB);
  G_WAIT_V(6); G_BAR;
  for (;;) {
    const bool has_next = gemm_unit(bid + (ui + 1) * nblk, nM, nN, npm, npn);
    const char* nA = has_next ? (const char*)Ag + (size_t)npm * tstepA : cA;
    const char* nB = has_next ? (const char*)Bg + (size_t)npn * tstepB : cB;
#pragma unroll 1
    for (int t = 0; t < nt; t += 2) {
      const bool last = (t == nt - 2);
      const char* a1 = cA + (size_t)(t + 1) * kstep;
      const char* a2 = last ? nA : cA + (size_t)(t + 2) * kstep;
      const char* b2 = last ? nB : cB + (size_t)(t + 2) * kstep;
      const char* a3 = a2 + kstep;
      const char* b3 = b2 + kstep;
      G_LDB(B0, 0, 0); G_SCHED; G_LDA(At, 0, 0); G_STAGE(G_SA(1, 1), a1 + hstepA, voffA);
      G_WAIT_L(8); G_BAR; G_WAIT_L(0); G_MMA(0, 0, At, B0); G_BAR; G_SCHED;
      G_LDB(B1, 0, 1); G_STAGE(G_SB(0, 0), b2, voffB);
      G_BAR; G_WAIT_L(0); G_MMA(0, 1, At, B1); G_BAR;
      G_LDA(At, 0, 1); G_STAGE(G_SA(0, 0), a2, voffA);
      G_BAR; G_WAIT_L(0); G_MMA(1, 0, At, B0); G_BAR; G_SCHED;
      G_STAGE(G_SB(0, 1), b2 + hstepB, voffB);
      G_WAIT_V(6); G_BAR; G_MMA(1, 1, At, B1); G_BAR;
      G_LDB(B0, 1, 0); G_SCHED; G_LDA(At, 1, 0); G_STAGE(G_SA(0, 1), a2 + hstepA, voffA);
      G_WAIT_L(8); G_BAR; G_WAIT_L(0); G_MMA(0, 0, At, B0); G_BAR; G_SCHED;
      G_LDB(B1, 1, 1); G_STAGE(G_SB(1, 0), b3, voffB);
      G_BAR; G_WAIT_L(0); G_MMA(0, 1, At, B1); G_BAR;
      G_LDA(At, 1, 1); G_STAGE(G_SA(1, 0), a3, voffA);
      G_BAR; G_WAIT_L(0); G_MMA(1, 0, At, B0); G_BAR; G_SCHED;
      G_STAGE(G_SB(1, 1), b3 + hstepB, voffB);
      G_WAIT_V(6); G_BAR; G_MMA(1, 1, At, B1); G_BAR;
    }
    E(acc, pm * BM, pn * BM, wr, wc, fr, fq);
    if (!has_next) break;
#pragma unroll
    for (int a = 0; a < 2; ++a)
#pragma unroll
      for (int b = 0; b < 2; ++b)
#pragma unroll
        for (int m = 0; m < 4; ++m)
#pragma unroll
          for (int n = 0; n < 2; ++n) acc[a][b][m][n] = (f32x4){0.f, 0.f, 0.f, 0.f};
    pm = npm; pn = npn; cA = nA; cB = nB; ++ui;
  }
  G_WAIT_V(0);
  if (wr == 0) G_BAR;
  G_BAR;
#undef G_SA
#undef G_SB
#undef G_STAGE
#undef G_LDA
#undef G_LDB
#undef G_MMA
}

struct EpiProj {
  static constexpr bool PERM = true;
  bf16_t* proj;
  DI void operator()(const f32x4 (&acc)[2][2][4][2], int brow, int bcol, int wr, int wc, int fr, int fq) const {
#pragma unroll
    for (int ai = 0; ai < 2; ++ai)
#pragma unroll
      for (int m = 0; m < 4; ++m) {
        const int row = brow + ai * 128 + wr * 64 + m * 16 + fr;
#pragma unroll
        for (int bj = 0; bj < 2; ++bj) {
          const int col = bcol + bj * 128 + wc * 32 + fq * 8;
          f32x4 v0 = acc[ai][bj][m][0], v1 = acc[ai][bj][m][1];
          if (bcol >= PIN && bj == 0) {
            v0.x = tanhf_(v0.x); v0.y = tanhf_(v0.y); v0.z = tanhf_(v0.z); v0.w = tanhf_(v0.w);
            v1.x = tanhf_(v1.x); v1.y = tanhf_(v1.y); v1.z = tanhf_(v1.z); v1.w = tanhf_(v1.w);
          }
          u32x4 pk = {pk2(v0.x, v0.y), pk2(v0.z, v0.w), pk2(v1.x, v1.y), pk2(v1.z, v1.w)};
          *(u32x4*)(proj + (size_t)row * NP + col) = pk;
        }
      }
  }
};
struct EpiLora {
  static constexpr bool PERM = false;
  float* lw; const float* w0; const float* a0;
  DI void operator()(const f32x4 (&acc)[2][2][4][2], int brow, int bcol, int wr, int wc, int fr, int fq) const {
#pragma unroll
    for (int ai = 0; ai < 2; ++ai)
#pragma unroll
      for (int m = 0; m < 4; ++m) {
        const int row = brow + ai * 128 + wr * 64 + m * 16 + fr;
#pragma unroll
        for (int bj = 0; bj < 2; ++bj)
#pragma unroll
          for (int n = 0; n < 2; ++n) {
            const int col = bcol + bj * 128 + wc * 32 + n * 16 + fq * 4;
            f32x4 v = acc[ai][bj][m][n], o;
            if (col < 512) {
              const f32x4 b = *(const f32x4*)(w0 + col);
#pragma unroll
              for (int j = 0; j < 4; ++j) { const float wl = v[j] + b[j]; o[j] = __expf(-sigmoidf_(wl) * 0.60653066f); }
            } else {
              const f32x4 b = *(const f32x4*)(a0 + col - 512);
#pragma unroll
              for (int j = 0; j < 4; ++j) o[j] = sigmoidf_(v[j] + b[j]);
            }
            *(f32x4*)(lw + (size_t)row * 1024 + col) = o;
          }
      }
  }
};
struct EpiBranch {
  static constexpr bool PERM = false;
  const bf16_t* proj; const float* bg; float* mf; bf16_t* mb; int kb;
  DI void operator()(const f32x4 (&acc)[2][2][4][2], int brow, int bcol, int wr, int wc, int fr, int fq) const {
#pragma unroll
    for (int ai = 0; ai < 2; ++ai)
#pragma unroll
      for (int m = 0; m < 4; ++m) {
        const int row = brow + ai * 128 + wr * 64 + m * 16 + fr;
#pragma unroll
        for (int bj = 0; bj < 2; ++bj)
#pragma unroll
          for (int n = 0; n < 2; ++n) {
            const int col = bcol + bj * 128 + wc * 32 + n * 16 + fq * 4;
            const f32x4 v = acc[ai][bj][m][n];
            const u32x2 gp = *(const u32x2*)(proj + (size_t)row * NP + C_GATE + kb * DM + col);
            const f32x4 b = *(const f32x4*)(bg + col);
            f32x4 o;
            o.x = sigmoidf_(__uint_as_float(gp.x << 16) + b.x) * v.x;
            o.y = sigmoidf_(__uint_as_float(gp.x & 0xffff0000u) + b.y) * v.y;
            o.z = sigmoidf_(__uint_as_float(gp.y << 16) + b.z) * v.z;
            o.w = sigmoidf_(__uint_as_float(gp.y & 0xffff0000u) + b.w) * v.w;
            float* mp = mf + (size_t)row * DM + col;
            if (kb > 0) o += *(const f32x4*)mp;
            if (kb < 3) *(f32x4*)mp = o;
            else { u32x2 pk = {pk2(o.x, o.y), pk2(o.z, o.w)}; *(u32x2*)(mb + (size_t)row * DM + col) = pk; }
          }
      }
  }
};
struct EpiOut {
  static constexpr bool PERM = false;
  const float* xin; float* xout;
  DI void operator()(const f32x4 (&acc)[2][2][4][2], int brow, int bcol, int wr, int wc, int fr, int fq) const {
#pragma unroll
    for (int ai = 0; ai < 2; ++ai)
#pragma unroll
      for (int m = 0; m < 4; ++m) {
        const int row = brow + ai * 128 + wr * 64 + m * 16 + fr;
#pragma unroll
        for (int bj = 0; bj < 2; ++bj)
#pragma unroll
          for (int n = 0; n < 2; ++n) {
            const int col = bcol + bj * 128 + wc * 32 + n * 16 + fq * 4;
            const size_t o = (size_t)row * DM + col;
            *(f32x4*)(xout + o) = *(const f32x4*)(xin + o) + acc[ai][bj][m][n];
          }
      }
  }
};

DI void branch_phase(LAS unsigned char* lds, CP p, int l, int bid, int nblk) {
  const int tid = ltid(), wid = __builtin_amdgcn_readfirstlane(tid >> 6), lane = tid & 63, wr = wid >> 2, wc = wid & 3, fr = lane & 15, fq = lane >> 4;
  unsigned voffA[2], voffB[2];
#pragma unroll
  for (int i = 0; i < 2; ++i) { int R, C; stage_rc(tid * 16 + i * 8192, R, C); const int Rb = (R & ~31) + perm32(R & 31); voffA[i] = (unsigned)(R * DM + C) * 2u; voffB[i] = (unsigned)(Rb * BW + C) * 2u; }
  const unsigned ldsw = (unsigned)wid * 1024u;
  const int aoff = lds_byte(wr * 64 + fr, fq * 8), boff = lds_byte(wc * 32 + fr, fq * 8);
#define BR_STAGE(bufoff, gbase, voff) do { _Pragma("unroll") for (int _i = 0; _i < 2; ++_i) \
    __builtin_amdgcn_global_load_lds((const unsigned*)((const char*)(gbase) + (voff)[_i]), (LAS unsigned*)(lds + (bufoff) + ldsw + _i * 8192), 16, 0, 0); } while (0)
  const bf16_t* ys = p->ys;
  const bf16_t* wbr = p->WtBr + (size_t)l * 4 * DM * BW;
  const bf16_t* proj = p->proj;
  const float* bgp = p->b_gate + (size_t)l * 4 * DM;
  bf16_t* mb = p->mergedb;
#pragma unroll 1
  for (int unit = bid; unit < 512; unit += nblk) {
    int pm, pn;
    if (nblk == 256) { const int bx = unit & 7, bj_ = (unit >> 3) & 31, bi = unit >> 8; pn = bj_ & 7; pm = bi * 32 + bx * 4 + (bj_ >> 3); }
    else { pm = unit >> 3; pn = unit & 7; }
    f32x4 acc[2][4][2], mg[2][4][2];
#pragma unroll
    for (int b = 0; b < 2; ++b)
#pragma unroll
      for (int m = 0; m < 4; ++m)
#pragma unroll
        for (int n = 0; n < 2; ++n) { acc[b][m][n] = (f32x4){0.f, 0.f, 0.f, 0.f}; mg[b][m][n] = (f32x4){0.f, 0.f, 0.f, 0.f}; }
    const char* Ab = (const char*)(ys + (size_t)(pm * 128) * DM);
    const char* Bb = (const char*)(wbr + (size_t)(pn * 256) * BW);
    __syncthreads();
    BR_STAGE(0, Ab, voffA); BR_STAGE(16384, Bb, voffB); BR_STAGE(32768, Bb + (size_t)128 * BW * 2, voffB);
    BR_STAGE(49152, Ab + 128, voffA); BR_STAGE(49152 + 16384, Bb + 128, voffB); BR_STAGE(49152 + 32768, Bb + (size_t)128 * BW * 2 + 128, voffB);
#pragma unroll 1
    for (int q = 0; q < 32; ++q) {
      const int cur = (q % 3) * 49152;
      if (q + 1 < 32) asm volatile("s_waitcnt vmcnt(6)" ::: "memory");
      else asm volatile("s_waitcnt vmcnt(0)" ::: "memory");
      __builtin_amdgcn_s_barrier();
      if (q + 2 < 32) {
        const int q2 = q + 2, kb2 = q2 >> 3, kt2 = q2 & 7, nb = (q2 % 3) * 49152;
        const char* a2 = Ab + (size_t)kb2 * BW * 2 + kt2 * 128;
        const char* b2 = Bb + (size_t)kb2 * DM * BW * 2 + kt2 * 128;
        BR_STAGE(nb, a2, voffA); BR_STAGE(nb + 16384, b2, voffB); BR_STAGE(nb + 32768, b2 + (size_t)128 * BW * 2, voffB);
      }
      bf16x8 At[4][2], Bf[2][2][2];
#pragma unroll
      for (int m = 0; m < 4; ++m)
#pragma unroll
        for (int k = 0; k < 2; ++k) At[m][k] = *(const LAS bf16x8*)(lds + cur + aoff + m * 2048 + k * 1024);
#pragma unroll
      for (int bj = 0; bj < 2; ++bj)
#pragma unroll
        for (int n = 0; n < 2; ++n)
#pragma unroll
          for (int k = 0; k < 2; ++k) Bf[bj][n][k] = *(const LAS bf16x8*)(lds + cur + 16384 + bj * 16384 + boff + n * 2048 + k * 1024);
#pragma unroll
      for (int bj = 0; bj < 2; ++bj)
#pragma unroll
        for (int m = 0; m < 4; ++m)
#pragma unroll
          for (int n = 0; n < 2; ++n)
#pragma unroll
            for (int k = 0; k < 2; ++k) acc[bj][m][n] = __builtin_amdgcn_mfma_f32_16x16x32_bf16(Bf[bj][n][k], At[m][k], acc[bj][m][n], 0, 0, 0);
      if ((q & 7) == 7) {
        const int kb = q >> 3;
#pragma unroll
        for (int m = 0; m < 4; ++m) {
          const int row = pm * 128 + wr * 64 + m * 16 + fr;
#pragma unroll
          for (int bj = 0; bj < 2; ++bj) {
            const int col = pn * 256 + bj * 128 + wc * 32 + fq * 8;
            const u32x4 gp = *(const u32x4*)(proj + (size_t)row * NP + C_GATE + kb * DM + col);
            const f32x4 b0 = *(const f32x4*)(bgp + kb * DM + col), b1 = *(const f32x4*)(bgp + kb * DM + col + 4);
            const f32x4 v0 = acc[bj][m][0], v1 = acc[bj][m][1];
            f32x4 o0, o1;
            o0.x = sigmoidf_(__uint_as_float(gp.x << 16) + b0.x) * v0.x;
            o0.y = sigmoidf_(__uint_as_float(gp.x & 0xffff0000u) + b0.y) * v0.y;
            o0.z = sigmoidf_(__uint_as_float(gp.y << 16) + b0.z) * v0.z;
            o0.w = sigmoidf_(__uint_as_float(gp.y & 0xffff0000u) + b0.w) * v0.w;
            o1.x = sigmoidf_(__uint_as_float(gp.z << 16) + b1.x) * v1.x;
            o1.y = sigmoidf_(__uint_as_float(gp.z & 0xffff0000u) + b1.y) * v1.y;
            o1.z = sigmoidf_(__uint_as_float(gp.w << 16) + b1.z) * v1.z;
            o1.w = sigmoidf_(__uint_as_float(gp.w & 0xffff0000u) + b1.w) * v1.w;
            mg[bj][m][0] += o0; mg[bj][m][1] += o1;
            acc[bj][m][0] = (f32x4){0.f, 0.f, 0.f, 0.f}; acc[bj][m][1] = (f32x4){0.f, 0.f, 0.f, 0.f};
          }
        }
      }
    }
#pragma unroll
    for (int m = 0; m < 4; ++m) {
      const int row = pm * 128 + wr * 64 + m * 16 + fr;
#pragma unroll
      for (int bj = 0; bj < 2; ++bj) {
        const int col = pn * 256 + bj * 128 + wc * 32 + fq * 8;
        const f32x4 o0 = mg[bj][m][0], o1 = mg[bj][m][1];
        u32x4 pk = {pk2(o0.x, o0.y), pk2(o0.z, o0.w), pk2(o1.x, o1.y), pk2(o1.z, o1.w)};
        *(u32x4*)(mb + (size_t)row * DM + col) = pk;
      }
    }
  }
  __syncthreads();
#undef BR_STAGE
}

DI float ldp(const bf16_t* proj, int t, int col) { return bf2f(proj[(size_t)t * NP + col]); }
DI void ld8(const bf16_t* ptr, float (&f)[8]) {
  const u32x4 v = *(const u32x4*)ptr;
  f[0] = __uint_as_float(v.x << 16); f[1] = __uint_as_float(v.x & 0xffff0000u);
  f[2] = __uint_as_float(v.y << 16); f[3] = __uint_as_float(v.y & 0xffff0000u);
  f[4] = __uint_as_float(v.z << 16); f[5] = __uint_as_float(v.z & 0xffff0000u);
  f[6] = __uint_as_float(v.w << 16); f[7] = __uint_as_float(v.w & 0xffff0000u);
}
DI void ld4(const bf16_t* ptr, float (&f)[4]) {
  const u32x2 v = *(const u32x2*)ptr;
  f[0] = __uint_as_float(v.x << 16); f[1] = __uint_as_float(v.x & 0xffff0000u);
  f[2] = __uint_as_float(v.y << 16); f[3] = __uint_as_float(v.y & 0xffff0000u);
}
DI u32x4 pack8(const float (&f)[8]) { u32x4 r = {pk2(f[0], f[1]), pk2(f[2], f[3]), pk2(f[4], f[5]), pk2(f[6], f[7])}; return r; }
DI float red8(float x) {
  x += dppf<0xB1>(x);
  x += dppf<0x4E>(x);
  x += dppf<0x141>(x);
  return x;
}

DI void rope_table_phase(CP p, int bid) {
  if (bid != 0) return;
  for (int i = ltid(); i < 1024; i += NTH) {
    const int pos = i >> 4, pi = i & 15;
    const float inv = exp2f(-(float)pi * (13.287712379549449f / 16.f));
    float sn, cs;
    sincosf((float)pos * inv, &sn, &cs);
    p->rope[2 * i] = cs;
    p->rope[2 * i + 1] = sn;
  }
}

DI void prep_a_phase(CP p, int l, int bid, int nblk) {
  const float* cw = p->conv_a_w + (size_t)l * 3 * BW;
  for (int i = bid * NTH + ltid(); i < T * 64; i += nblk * NTH) {
    const int c = (i & 63) * 8, t = i >> 6, s = t & (SEQ - 1);
    const bf16_t* row = p->proj + (size_t)t * NP;
    float cg[8], ax[8], u0[8], um[8], up[8], bg[8], az[8], o[8];
    ld8(row + C_ACG + c, cg); ld8(row + C_AX + c, ax);
#pragma unroll
    for (int k = 0; k < 8; ++k) { u0[k] = cg[k] * ax[k]; um[k] = 0.f; up[k] = 0.f; }
    if (s > 0) {
      ld8(row - NP + C_ACG + c, cg); ld8(row - NP + C_AX + c, ax);
#pragma unroll
      for (int k = 0; k < 8; ++k) um[k] = cg[k] * ax[k];
    }
    if (s < SEQ - 1) {
      ld8(row + NP + C_ACG + c, cg); ld8(row + NP + C_AX + c, ax);
#pragma unroll
      for (int k = 0; k < 8; ++k) up[k] = cg[k] * ax[k];
    }
    ld8(row + C_ABG + c, bg); ld8(row + C_AZ + c, az);
    const f32x4 w0a = *(const f32x4*)(cw + c), w0b = *(const f32x4*)(cw + c + 4), w1a = *(const f32x4*)(cw + BW + c), w1b = *(const f32x4*)(cw + BW + c + 4),
                w2a = *(const f32x4*)(cw + 2 * BW + c), w2b = *(const f32x4*)(cw + 2 * BW + c + 4);
#pragma unroll
    for (int k = 0; k < 8; ++k) {
      const float w0 = k < 4 ? w0a[k & 3] : w0b[k & 3], w1 = k < 4 ? w1a[k & 3] : w1b[k & 3], w2 = k < 4 ? w2a[k & 3] : w2b[k & 3];
      o[k] = bg[k] * (w0 * um[k] + w1 * u0[k] + w2 * up[k]) * siluf_(az[k]);
    }
    *(u32x4*)(p->ys + (size_t)t * DM + c) = pack8(o);
  }
}

DI void prep_qkv_phase(CP p, int l, int bid, int nblk) {
  const int tid = ltid(), wave = tid >> 6, lane = tid & 63, rsub = lane >> 3, chunk = lane & 7;
  const f32x4 gqa = *(const f32x4*)(p->q_norm_g + l * 64 + chunk * 8), gqb = *(const f32x4*)(p->q_norm_g + l * 64 + chunk * 8 + 4);
  const f32x4 gka = *(const f32x4*)(p->k_norm_g + l * 64 + chunk * 8), gkb = *(const f32x4*)(p->k_norm_g + l * 64 + chunk * 8 + 4);
  const int half = chunk >> 2, pbase = (chunk & 1) * 8;
  const bool second = (chunk & 2) != 0;
  for (int wi = bid * 8 + wave; wi < T * 10 / 8; wi += nblk * 8) {
    const int ri = wi * 8 + rsub, t = ri / 10, slot = ri % 10, s = t & (SEQ - 1);
    const int col = slot < 8 ? (C_Q + slot * 64) : (C_K + (slot - 8) * 64);
    float x[8], o[8];
    ld8(p->proj + (size_t)t * NP + col + chunk * 8, x);
    float ss = 0.f;
#pragma unroll
    for (int k = 0; k < 8; ++k) ss += x[k] * x[k];
    ss = red8(ss);
    const float rs = rsqrtf(ss * (1.f / 64.f) + 1e-6f);
    const int pos = half ? (s & 63) : (s >> 6);
    const f32x4* tb = (const f32x4*)(p->rope + (size_t)(pos * 16 + pbase) * 2);
    const f32x4 cs0 = tb[0], cs1 = tb[1], cs2 = tb[2], cs3 = tb[3];
#pragma unroll
    for (int k = 0; k < 8; ++k) {
      const float gq = k < 4 ? gqa[k & 3] : gqb[k & 3], gk = k < 4 ? gka[k & 3] : gkb[k & 3];
      const float xn = x[k] * rs * (slot < 8 ? gq : gk);
      const float other = dppf<0x4E>(xn);
      const f32x4 cs = (k >> 1) == 0 ? cs0 : ((k >> 1) == 1 ? cs1 : ((k >> 1) == 2 ? cs2 : cs3));
      const float cv = cs[(k & 1) * 2], sv = cs[(k & 1) * 2 + 1];
      o[k] = second ? (xn * cv + other * sv) : (xn * cv - other * sv);
    }
    bf16_t* dst = slot < 8 ? (p->qn + (size_t)t * 512 + slot * 64 + chunk * 8) : (p->kn + (size_t)t * 128 + (slot - 8) * 64 + chunk * 8);
    *(u32x4*)dst = pack8(o);
  }
}

DI void prep_vt_phase(CP p, int bid, int nblk) {
  for (int i = bid * NTH + ltid(); i < (T / 8) * 16; i += nblk * NTH) {
    const int chunk = i & 7, kvh = (i >> 3) & 1, tg = i >> 4;
    const int t0 = tg * 8, b = t0 / SEQ, s0 = t0 & (SEQ - 1);
    u32x4 in[8];
#pragma unroll
    for (int r = 0; r < 8; ++r) in[r] = *(const u32x4*)(p->proj + (size_t)(t0 + r) * NP + C_V + kvh * 64 + chunk * 8);
#pragma unroll
    for (int k = 0; k < 8; ++k) {
      unsigned e[8];
#pragma unroll
      for (int r = 0; r < 8; ++r) { const unsigned w = in[r][k >> 1]; e[r] = (k & 1) ? (w >> 16) : (w & 0xffffu); }
      u32x4 o = {e[0] | (e[1] << 16), e[2] | (e[3] << 16), e[4] | (e[5] << 16), e[6] | (e[7] << 16)};
      *(u32x4*)(p->vT + ((size_t)((b * 2 + kvh) * 64 + chunk * 8 + k)) * SEQ + s0) = o;
    }
  }
}

DI void prep_rwkv_phase(CP p, int l, int bid, int nblk) {
  const int tid = ltid(), wave = tid >> 6, lane = tid & 63, sub = lane >> 4, kq = lane & 15;
  for (int wi = bid * 8 + wave; wi < T * 2; wi += nblk * 8) {
    const int it = wi * 4 + sub, h = it & 7, t = it >> 3, s = t & (SEQ - 1), b = t / SEQ, c = h * 64 + kq * 4;
    const bf16_t* row = p->proj + (size_t)t * NP;
    float rc[4], kc[4], vc[4];
    ld4(row + C_CR + c, rc); ld4(row + C_CK + c, kc); ld4(row + C_CV + c, vc);
    const f32x4 kkp = *(const f32x4*)(p->k_k + l * BW + c), kap = *(const f32x4*)(p->k_a + l * BW + c), rkp = *(const f32x4*)(p->r_k + l * BW + c);
#pragma unroll
    for (int e = 0; e < 2; ++e) {
      const bool valid = e ? (s < SEQ - 1) : (s > 0);
      const bf16_t* prow = e ? (row + NP) : (row - NP);
      float rp[4] = {0.f, 0.f, 0.f, 0.f}, kp[4] = {0.f, 0.f, 0.f, 0.f}, vp[4] = {0.f, 0.f, 0.f, 0.f};
      if (valid) { ld4(prow + C_CR + c, rp); ld4(prow + C_CK + c, kp); ld4(prow + C_CV + c, vp); }
      const float* mu = p->mu_rkv + (size_t)(l * 2 + e) * 3 * BW + c;
      const f32x4 mur = *(const f32x4*)mu, muk = *(const f32x4*)(mu + BW), muv = *(const f32x4*)(mu + 2 * BW);
      const float* lwp = p->lw + ((size_t)e * T + t) * 1024 + c;
      const f32x4 dec = *(const f32x4*)lwp, a = *(const f32x4*)(lwp + 512);
      f32x4 r2, k2, v2, kk, kt;
      float n2 = 0.f;
#pragma unroll
      for (int i = 0; i < 4; ++i) {
        r2[i] = rc[i] + (rp[i] - rc[i]) * mur[i];
        k2[i] = kc[i] + (kp[i] - kc[i]) * muk[i];
        v2[i] = vc[i] + (vp[i] - vc[i]) * muv[i];
        kk[i] = k2[i] * kkp[i];
        n2 += kk[i] * kk[i];
        kt[i] = k2[i] * (1.f + (a[i] - 1.f) * kap[i]);
      }
      n2 = red16(n2);
      const float rn = 1.f / fmaxf(sqrtf(n2), 1e-12f);
      float bs = 0.f;
#pragma unroll
      for (int i = 0; i < 4; ++i) { kk[i] *= rn; bs += r2[i] * kt[i] * rkp[i]; }
      bs = red16(bs);
      *(f32x4*)(p->bonusv + ((size_t)e * T + t) * BW + c) = v2 * bs;
      const int j = e ? (SEQ - 1 - s) : s;
      float* si = p->SI + (((size_t)((e * 2 + b) * 8 + h)) * SEQ + j) * 384 + kq * 4;
      *(f32x4*)(si) = r2;
      *(f32x4*)(si + 64) = dec;
      *(f32x4*)(si + 128) = kt;
      *(f32x4*)(si + 192) = -kk;
      *(f32x4*)(si + 256) = kk * a;
      *(f32x4*)(si + 320) = v2;
    }
  }
}

DI void convd_phase(CP p, int l, float* lds, int bid, int nblk) {
  const int c = ltid(), wave = c >> 6, lane = c & 63;
  const float* dw = p->dw_w + (size_t)l * 31 * BW;
  float wreg[31];
#pragma unroll
  for (int j = 0; j < 31; ++j) wreg[j] = dw[j * BW + c];
  const float bias = p->dw_b[l * BW + c], lg = p->ln_g[l * BW + c], lb = p->ln_b[l * BW + c];
  float* tr = lds;
  float* st = lds + 32 * 512;
  for (int blk = bid; blk < T / 32; blk += nblk) {
    const int t0 = blk * 32, s0 = t0 & (SEQ - 1);
    float u[62];
#pragma unroll
    for (int i = 0; i < 62; ++i) {
      const int s = s0 - 15 + i;
      u[i] = 0.f;
      if (s >= 0 && s < SEQ) {
        const bf16_t* row = p->proj + (size_t)(t0 - 15 + i) * NP;
        u[i] = bf2f(row[C_DV + c]) * sigmoidf_(bf2f(row[C_DG + c]));
      }
    }
    float acc[32];
    __syncthreads();
#pragma unroll
    for (int tk = 0; tk < 32; ++tk) {
      float a = bias;
#pragma unroll
      for (int j = 0; j < 31; ++j) a += wreg[j] * u[tk + j];
      acc[tk] = a;
      tr[tk * 512 + c] = a;
    }
    __syncthreads();
#pragma unroll
    for (int q = 0; q < 4; ++q) {
      const int tk = wave * 4 + q;
      float xv[8], sm = 0.f;
#pragma unroll
      for (int i = 0; i < 8; ++i) { xv[i] = tr[tk * 512 + lane + 64 * i]; sm += xv[i]; }
      const float mean = wave_sum(sm) * (1.f / BW);
      float sq = 0.f;
#pragma unroll
      for (int i = 0; i < 8; ++i) { const float d = xv[i] - mean; sq += d * d; }
      const float var = wave_sum(sq) * (1.f / BW);
      if (lane == 0) { st[tk * 2] = mean; st[tk * 2 + 1] = rsqrtf(var + 1e-5f); }
    }
    __syncthreads();
#pragma unroll
    for (int tk = 0; tk < 32; ++tk) {
      const float mean = st[tk * 2], rstd = st[tk * 2 + 1];
      const float un = (acc[tk] - mean) * rstd * lg + lb;
      const float yd = siluf_(un) * siluf_(ldp(p->proj, t0 + tk, C_DZ + c));
      p->ys[(size_t)(t0 + tk) * DM + 3 * BW + c] = f2bf(yd);
    }
  }
}

#define MFMA32(a, b, c) __builtin_amdgcn_mfma_f32_32x32x16_bf16((a), (b), (c), 0, 0, 0)
DI void attn_phase(CP p, int l, char* smem, int bid, int nblk) {
  const int tid = ltid(), wave = tid >> 6, lane = tid & 63, r = lane & 31, hh = lane >> 5;
  const float gq = wave_max(fabsf(p->q_norm_g[l * 64 + lane])), gk = wave_max(fabsf(p->k_norm_g[l * 64 + lane]));
  const float Mb = 8.f * gq * gk * 1.0001f;
  const float c1 = 0.125f * 1.44269504f, c2 = Mb * 1.44269504f;
  const int row = tid >> 3, c16 = tid & 7;
  const int woff = row * 128 + ((c16 ^ ((row >> 1) & 7)) << 4);
  for (int item = bid; item < 256; item += nblk) {
    const int b = item >> 7, head = (item >> 4) & 7, qt = item & 15, kvh = head >> 2;
    const int t0 = b * SEQ + qt * 256 + wave * 32;
    bf16x8 qf[4];
#pragma unroll
    for (int s = 0; s < 4; ++s) qf[s] = *(const bf16x8*)(p->qn + (size_t)(t0 + r) * 512 + head * 64 + 16 * s + 8 * hh);
    f32x16 o0, o1;
#pragma unroll
    for (int i = 0; i < 16; ++i) { o0[i] = 0.f; o1[i] = 0.f; }
    float lsum = 0.f;
    const bf16_t* kbase = p->kn + (size_t)(b * SEQ) * 128 + kvh * 64;
    const bf16_t* vbase = p->vT + (size_t)((b * 2 + kvh) * 64) * SEQ;
    u32x4 kreg = *(const u32x4*)(kbase + (size_t)row * 128 + c16 * 8);
    u32x4 vreg = *(const u32x4*)(vbase + (size_t)row * SEQ + c16 * 8);
    __syncthreads();
    *(u32x4*)(smem + woff) = kreg;
    *(u32x4*)(smem + 16384 + woff) = vreg;
    __syncthreads();
#pragma unroll 1
    for (int kt = 0; kt < 64; ++kt) {
      const int cur = kt & 1;
      if (kt + 1 < 64) {
        kreg = *(const u32x4*)(kbase + (size_t)((kt + 1) * 64 + row) * 128 + c16 * 8);
        vreg = *(const u32x4*)(vbase + (size_t)row * SEQ + (kt + 1) * 64 + c16 * 8);
      }
      const char* kb_ = smem + cur * 8192;
      const char* vb_ = smem + 16384 + cur * 8192;
#pragma unroll
      for (int kb = 0; kb < 2; ++kb) {
        f32x16 sacc;
#pragma unroll
        for (int i = 0; i < 16; ++i) sacc[i] = 0.f;
        const int krow_ = kb * 32 + r;
#pragma unroll
        for (int s = 0; s < 4; ++s) {
          const int c = 2 * s + hh;
          const bf16x8 kf = *(const bf16x8*)(kb_ + krow_ * 128 + ((c ^ ((krow_ >> 1) & 7)) << 4));
          sacc = MFMA32(kf, qf[s], sacc);
        }
        float pv[16];
#pragma unroll
        for (int i = 0; i < 16; ++i) { pv[i] = __builtin_amdgcn_exp2f(sacc[i] * c1 - c2); lsum += pv[i]; }
#pragma unroll
        for (int s2 = 0; s2 < 2; ++s2) {
          u32x4 pp = {pk2(pv[8 * s2], pv[8 * s2 + 1]), pk2(pv[8 * s2 + 2], pv[8 * s2 + 3]), pk2(pv[8 * s2 + 4], pv[8 * s2 + 5]), pk2(pv[8 * s2 + 6], pv[8 * s2 + 7])};
          const bf16x8 pf = __builtin_bit_cast(bf16x8, pp);
          const int cA = kb * 4 + 2 * s2;
#pragma unroll
          for (int dblk = 0; dblk < 2; ++dblk) {
            const int drow = dblk * 32 + r;
            const int sw = (drow >> 1) & 7;
            const u32x2 lo = *(const u32x2*)(vb_ + drow * 128 + ((cA ^ sw) << 4) + 8 * hh);
            const u32x2 hi = *(const u32x2*)(vb_ + drow * 128 + (((cA + 1) ^ sw) << 4) + 8 * hh);
            u32x4 vv = {lo.x, lo.y, hi.x, hi.y};
            const bf16x8 vf = __builtin_bit_cast(bf16x8, vv);
            if (dblk == 0) o0 = MFMA32(vf, pf, o0); else o1 = MFMA32(vf, pf, o1);
          }
        }
      }
      if (kt + 1 < 64) {
        *(u32x4*)(smem + (cur ^ 1) * 8192 + woff) = kreg;
        *(u32x4*)(smem + 16384 + (cur ^ 1) * 8192 + woff) = vreg;
      }
      __syncthreads();
    }
    const float ltot = lsum + __shfl_xor(lsum, 32);
    const float linv = 1.f / ltot;
    const int t = t0 + r;
#pragma unroll
    for (int dblk = 0; dblk < 2; ++dblk)
#pragma unroll
      for (int g = 0; g < 4; ++g) {
        const int d0 = dblk * 32 + 8 * g + 4 * hh;
        const u32x2 zp = *(const u32x2*)(p->proj + (size_t)t * NP + C_BZ + head * 64 + d0);
        float z[4] = {__uint_as_float(zp.x << 16), __uint_as_float(zp.x & 0xffff0000u), __uint_as_float(zp.y << 16), __uint_as_float(zp.y & 0xffff0000u)};
        float ov[4];
#pragma unroll
        for (int j = 0; j < 4; ++j) ov[j] = ((dblk == 0) ? o0[4 * g + j] : o1[4 * g + j]) * linv * siluf_(z[j]);
        u32x2 pk = {pk2(ov[0], ov[1]), pk2(ov[2], ov[3])};
        *(u32x2*)(p->ys + (size_t)t * DM + BW + head * 64 + d0) = pk;
      }
  }
}

typedef float f32x2 __attribute__((ext_vector_type(2)));
#define LDS_BARRIER() asm volatile("s_waitcnt lgkmcnt(0)\n\ts_barrier" ::: "memory")
DI void scan_item(CP p, int l, char* smem, int item) {
  const int tid = ltid(), wave = tid >> 6, lane = tid & 63, kq = lane & 15, rw = lane >> 4;
  const int x = item & 7, jx = item >> 3;
  const int chain = x * 4 + (jx >> 2), quarter = jx & 3;
  const int e = chain >> 4, b = (chain >> 3) & 1, h = chain & 7;
  const float* si = p->SI + (size_t)chain * SEQ * 384;
  constexpr int CH = 32, NCH = SEQ / CH;
  __syncthreads();
  if (wave >= 4) {
    const int g = (tid - 256) >> 4, c4 = h * 64 + kq * 4;
    const f32x4 kkp = *(const f32x4*)(p->k_k + l * BW + c4), kap = *(const f32x4*)(p->k_a + l * BW + c4), rkp = *(const f32x4*)(p->r_k + l * BW + c4);
    const float* mu = p->mu_rkv + (size_t)(l * 2 + e) * 3 * BW + c4;
    const f32x4 mur = *(const f32x4*)mu, muk = *(const f32x4*)(mu + BW), muv = *(const f32x4*)(mu + 2 * BW);
    const bf16_t* projb = p->proj;
    const float* lwb = p->lw + (size_t)e * T * 1024;
    float* bonb = p->bonusv + (size_t)e * T * BW;
    u32x2 in_c[2][3], in_p[2][3];
    f32x4 in_d[2], in_a[2];
#define SC_LOAD(CI) do { _Pragma("unroll") for (int ps = 0; ps < 2; ++ps) { \
      const int j_ = (CI) * CH + ps * 16 + g; const int s_ = e ? (SEQ - 1 - j_) : j_; const int t_ = b * SEQ + s_; \
      const bool valid_ = e ? (s_ < SEQ - 1) : (s_ > 0); \
      const bf16_t* row_ = projb + (size_t)t_ * NP + c4; const bf16_t* prow_ = valid_ ? (e ? row_ + NP : row_ - NP) : row_; \
      in_c[ps][0] = *(const u32x2*)(row_ + C_CR); in_c[ps][1] = *(const u32x2*)(row_ + C_CK); in_c[ps][2] = *(const u32x2*)(row_ + C_CV); \
      in_p[ps][0] = *(const u32x2*)(prow_ + C_CR); in_p[ps][1] = *(const u32x2*)(prow_ + C_CK); in_p[ps][2] = *(const u32x2*)(prow_ + C_CV); \
      const float* lw_ = lwb + (size_t)t_ * 1024 + c4; in_d[ps] = *(const f32x4*)lw_; in_a[ps] = *(const f32x4*)(lw_ + 512); } } while (0)
#define SC_UNPK(U, F) do { F[0] = __uint_as_float(U.x << 16); F[1] = __uint_as_float(U.x & 0xffff0000u); F[2] = __uint_as_float(U.y << 16); F[3] = __uint_as_float(U.y & 0xffff0000u); } while (0)
#define SC_BUILD(CI, BUF) do { _Pragma("unroll") for (int ps = 0; ps < 2; ++ps) { \
      const int j_ = (CI) * CH + ps * 16 + g; const int s_ = e ? (SEQ - 1 - j_) : j_; const int t_ = b * SEQ + s_; \
      const bool valid_ = e ? (s_ < SEQ - 1) : (s_ > 0); \
      float rc[4], kc[4], vc[4], rp[4], kp[4], vp[4]; \
      SC_UNPK(in_c[ps][0], rc); SC_UNPK(in_c[ps][1], kc); SC_UNPK(in_c[ps][2], vc); SC_UNPK(in_p[ps][0], rp); SC_UNPK(in_p[ps][1], kp); SC_UNPK(in_p[ps][2], vp); \
      const f32x4 dec = in_d[ps], a = in_a[ps]; \
      f32x4 r2, k2, v2, kk, kt; float n2 = 0.f; \
      _Pragma("unroll") for (int i = 0; i < 4; ++i) { \
        const float rpi = valid_ ? rp[i] : 0.f, kpi = valid_ ? kp[i] : 0.f, vpi = valid_ ? vp[i] : 0.f; \
        r2[i] = rc[i] + (rpi - rc[i]) * mur[i]; k2[i] = kc[i] + (kpi - kc[i]) * muk[i]; v2[i] = vc[i] + (vpi - vc[i]) * muv[i]; \
        kk[i] = k2[i] * kkp[i]; n2 += kk[i] * kk[i]; kt[i] = k2[i] * (1.f + (a[i] - 1.f) * kap[i]); } \
      n2 = red16(n2); const float rn = 1.f / fmaxf(sqrtf(n2), 1e-12f); float bs = 0.f; \
      _Pragma("unroll") for (int i = 0; i < 4; ++i) { kk[i] *= rn; bs += r2[i] * kt[i] * rkp[i]; } \
      bs = red16(bs); \
      if (quarter == 0) *(f32x4*)(bonb + (size_t)t_ * BW + c4) = v2 * bs; \
      float* so_ = (float*)((BUF) + (ps * 16 + g) * 1536) + kq * 4; \
      *(f32x4*)(so_) = r2; *(f32x4*)(so_ + 64) = dec; *(f32x4*)(so_ + 128) = kt; *(f32x4*)(so_ + 192) = -kk; *(f32x4*)(so_ + 256) = kk * a; *(f32x4*)(so_ + 320) = v2; } } while (0)
    SC_LOAD(0);
    SC_BUILD(0, smem);
    SC_LOAD(1);
    LDS_BARRIER();
#pragma unroll 1
    for (int c = 0; c < NCH; ++c) {
      if (c + 1 < NCH) SC_BUILD(c + 1, smem + ((c + 1) & 1) * 49152);
      if (c + 2 < NCH) SC_LOAD(c + 2);
      LDS_BARRIER();
    }
#undef SC_LOAD
#undef SC_UNPK
#undef SC_BUILD
  } else {
    __builtin_amdgcn_s_setprio(3);
    const int v = quarter * 16 + wave * 4 + rw;
    f32x2 sA = {0.f, 0.f}, sB = {0.f, 0.f};
    float* yout = p->yraw + ((size_t)e * T + (size_t)b * SEQ) * BW + h * 64 + v;
    LDS_BARRIER();
#pragma unroll 1
    for (int c = 0; c < NCH; ++c) {
      const float* sb = (const float*)(smem + (c & 1) * 49152);
      {
        float ykeep = 0.f;
#define LD_STEP(R4, W4, KT4, KN4, BB4, VV, STP) do { const float* st_ = (STP); R4 = *(const f32x4*)(st_ + kq * 4); W4 = *(const f32x4*)(st_ + 64 + kq * 4); \
          KT4 = *(const f32x4*)(st_ + 128 + kq * 4); KN4 = *(const f32x4*)(st_ + 192 + kq * 4); BB4 = *(const f32x4*)(st_ + 256 + kq * 4); VV = st_[320 + v]; } while (0)
        f32x4 r4, w4, kt4, kn4, bb4, r4b, w4b, kt4b, kn4b, bb4b;
        float vv, vvb;
        LD_STEP(r4, w4, kt4, kn4, bb4, vv, sb);
        LD_STEP(r4b, w4b, kt4b, kn4b, bb4b, vvb, sb + 384);
#pragma unroll
        for (int jj = 0; jj < 32; ++jj) {
          f32x4 r4c = r4b, w4c = w4b, kt4c = kt4b, kn4c = kn4b, bb4c = bb4b;
          float vvc = vvb;
          if (jj + 2 < 32) LD_STEP(r4c, w4c, kt4c, kn4c, bb4c, vvc, sb + (jj + 2) * 384);
          const f32x2 knA = {kn4.x, kn4.y}, knB = {kn4.z, kn4.w}, wA = {w4.x, w4.y}, wB = {w4.z, w4.w}, ktA = {kt4.x, kt4.y}, ktB = {kt4.z, kt4.w},
                      bbA = {bb4.x, bb4.y}, bbB = {bb4.z, bb4.w}, rA = {r4.x, r4.y}, rB = {r4.z, r4.w};
          f32x2 t = sA * knA;
          t = sB * knB + t;
          const float sa = red16(t.x + t.y);
          const f32x2 vv2 = {vv, vv};
          const f32x2 mA = sA * wA + vv2 * ktA, mB = sB * wB + vv2 * ktB;
          const f32x2 sa2 = {sa, sa};
          sA = sa2 * bbA + mA;
          sB = sa2 * bbB + mB;
          f32x2 ty = sA * rA;
          ty = sB * rB + ty;
          const float y = red16(ty.x + ty.y);
          ykeep = (kq == (jj & 15)) ? y : ykeep;
          if ((jj & 15) == 15) {
            const int j = c * CH + (jj & 16) + kq;
            const int so = e ? (SEQ - 1 - j) : j;
            yout[(size_t)so * BW] = ykeep;
          }
          r4 = r4b; w4 = w4b; kt4 = kt4b; kn4 = kn4b; bb4 = bb4b; vv = vvb;
          r4b = r4c; w4b = w4c; kt4b = kt4c; kn4b = kn4c; bb4b = bb4c; vvb = vvc;
        }
#undef LD_STEP
      }
      LDS_BARRIER();
    }
    __builtin_amdgcn_s_setprio(0);
  }
}

DI void combine_phase(CP p, int l, int bid, int nblk) {
  const int tid = ltid(), wave = tid >> 6, lane = tid & 63, sub = lane >> 4, kq = lane & 15;
  for (int wi = bid * 8 + wave; wi < T * 2; wi += nblk * 8) {
    const int it = wi * 4 + sub, h = it & 7, t = it >> 3, c = h * 64 + kq * 4;
    const f32x4 g = *(const f32x4*)(p->gn_g + l * BW + c), gb = *(const f32x4*)(p->gn_b + l * BW + c);
    f32x4 tot = {0.f, 0.f, 0.f, 0.f};
#pragma unroll
    for (int e = 0; e < 2; ++e) {
      const f32x4 y = *(const f32x4*)(p->yraw + ((size_t)e * T + t) * BW + c);
      const float mean = red16(y.x + y.y + y.z + y.w) * (1.f / 64.f);
      const f32x4 d = y - mean;
      const float var = red16(d.x * d.x + d.y * d.y + d.z * d.z + d.w * d.w) * (1.f / 64.f);
      const float rstd = rsqrtf(var + 64e-5f);
      tot += d * rstd * g + gb + *(const f32x4*)(p->bonusv + ((size_t)e * T + t) * BW + c);
    }
    float z[4];
    ld4(p->proj + (size_t)t * NP + C_CZ + c, z);
    u32x2 pk = {pk2(tot.x * siluf_(z[0]), tot.y * siluf_(z[1])), pk2(tot.z * siluf_(z[2]), tot.w * siluf_(z[3]))};
    *(u32x2*)(p->ys + (size_t)t * DM + 2 * BW + c) = pk;
  }
}

#define XB_TMO      128
#define XB_XCNT(j)  (256  + 64 * (j))
#define XB_XSUB(j)  (1280 + 64 * (j))
#define XB_XGEN(j)  (2304 + 64 * (j))
#define XB_TOP      3328
#define XB_TOPGEN   3392
#define XCD_BAR_WORDS 3456
#define XB_SPIN_CAP (1u << 18)
DI unsigned xb_ld(unsigned* p) { return __hip_atomic_load(p, __ATOMIC_RELAXED, __HIP_MEMORY_SCOPE_AGENT); }
DI unsigned xb_add(unsigned* p, unsigned v) { return __hip_atomic_fetch_add(p, v, __ATOMIC_RELAXED, __HIP_MEMORY_SCOPE_AGENT); }
DI unsigned xb_xcc_id() { return (unsigned)__builtin_amdgcn_s_getreg((3 << 11) | 20) & 0xFu; }
#define XB_SPIN(cond, bar) do { unsigned _sp = 0; while (cond) { __builtin_amdgcn_s_sleep(1); \
    if ((++_sp & 255u) == 0u) { if (xb_ld(&(bar)[XB_TMO])) break; if (_sp > XB_SPIN_CAP) { atomicAdd(&(bar)[XB_TMO], 1u); break; } } } } while (0)
struct XcdBarrier { unsigned* bar; unsigned x; volatile LAS unsigned* st; };
DI XcdBarrier xcd_barrier_post(unsigned* bar, volatile LAS unsigned* st) {
  XcdBarrier b; b.bar = bar; b.x = xb_xcc_id(); b.st = st;
  if (threadIdx.x == 0) (void)xb_add(&bar[XB_XCNT(b.x)], 1u);
  return b;
}
DI void xcd_barrier_complete(unsigned* bar, unsigned x, unsigned& nloc, unsigned& nx) {
  const unsigned G = gridDim.x * gridDim.y * gridDim.z;
  unsigned sum, cnt, mine, sp = 0u;
  for (;;) {
    sum = 0u; cnt = 0u; mine = 0u;
#pragma unroll
    for (unsigned j = 0; j < 16; ++j) { const unsigned c = xb_ld(&bar[XB_XCNT(j)]); sum += c; cnt += (c > 0u) ? 1u : 0u; mine = (j == x) ? c : mine; }
    if (sum == G) break;
    __builtin_amdgcn_s_sleep(1);
    if ((++sp & 255u) == 0u) { if (xb_ld(&bar[XB_TMO])) break; if (sp > XB_SPIN_CAP) { atomicAdd(&bar[XB_TMO], 1u); break; } }
  }
  nloc = mine > 0u ? mine : 1u; nx = cnt > 0u ? cnt : 1u;
}
DI void xcd_barrier(const XcdBarrier& b) {
  asm volatile("s_waitcnt vmcnt(0)" ::: "memory");
  __syncthreads();
  if (threadIdx.x == 0) {
    unsigned* bar = b.bar;
    __builtin_amdgcn_s_waitcnt(0);
    unsigned nloc = b.st[0], nx = b.st[1];
    if (nloc == 0u) { xcd_barrier_complete(bar, b.x, nloc, nx); b.st[0] = nloc; b.st[1] = nx; }
    const unsigned old = xb_add(&bar[XB_XSUB(b.x)], 1u);
    const unsigned gen = old / nloc;
    if (old + 1u == (gen + 1u) * nloc) {
      __builtin_amdgcn_fence(__ATOMIC_RELEASE, "agent");
      asm volatile("s_waitcnt vmcnt(0)" ::: "memory");
      const unsigned og = xb_add(&bar[XB_TOP], 1u);
      const unsigned tg = og / nx;
      if (og + 1u == (tg + 1u) * nx) xb_add(&bar[XB_TOPGEN], 1u);
      else XB_SPIN(xb_ld(&bar[XB_TOPGEN]) == tg, bar);
      __builtin_amdgcn_fence(__ATOMIC_ACQUIRE, "agent");
      xb_add(&bar[XB_XGEN(b.x)], 1u);
      asm volatile("s_waitcnt vmcnt(0)" ::: "memory");
    } else {
      XB_SPIN(xb_ld(&bar[XB_XGEN(b.x)]) == gen, bar);
      __builtin_amdgcn_fence(__ATOMIC_ACQUIRE, "agent");
      asm volatile("s_waitcnt vmcnt(0)" ::: "memory");
    }
  }
  __syncthreads();
}

DI void sub_arrive(unsigned* ctr) {
  asm volatile("s_waitcnt vmcnt(0)" ::: "memory");
  __syncthreads();
  if (threadIdx.x == 0) {
    __builtin_amdgcn_fence(__ATOMIC_RELEASE, "agent");
    asm volatile("s_waitcnt vmcnt(0)" ::: "memory");
    (void)__hip_atomic_fetch_add(ctr, 1u, __ATOMIC_RELAXED, __HIP_MEMORY_SCOPE_AGENT);
  }
}
DI void sub_wait(unsigned* ctr, unsigned target) {
  __syncthreads();
  if (threadIdx.x == 0) {
    unsigned sp = 0;
    while (__hip_atomic_load(ctr, __ATOMIC_RELAXED, __HIP_MEMORY_SCOPE_AGENT) < target) { __builtin_amdgcn_s_sleep(1); if (++sp > (1u << 22)) break; }
    __builtin_amdgcn_fence(__ATOMIC_ACQUIRE, "agent");
    asm volatile("s_waitcnt vmcnt(0)" ::: "memory");
  }
  __syncthreads();
}

#ifndef DUP_MASK
#define DUP_MASK 0
#endif
#define REP(bit) for (int rep_ = 0; rep_ < 1 + ((DUP_MASK >> (bit)) & 1); ++rep_)
__global__ __launch_bounds__(NTH) void mega(P p) {
  extern __shared__ __attribute__((aligned(16))) unsigned char shm[];
  cg::grid_group grid = cg::this_grid();
  const int bid = blockIdx.x, nblk = gridDim.x;
  LAS unsigned char* lds = (LAS unsigned char*)shm;
  const CP kp = (CP)__builtin_amdgcn_kernarg_segment_ptr();
  __shared__ uint4 xb_words;
  if (threadIdx.x == 0) xb_words = make_uint4(0u, 0u, 0u, 0u);
  __syncthreads();
  const XcdBarrier xb = xcd_barrier_post(kp->bar, (volatile LAS unsigned*)&xb_words);
#define GSYNC() xcd_barrier(xb)
#define PP launder(kp)
  REP(0) { tconv_range(PP, (float*)shm, 0, 0, TC_L, bid, nblk);
  if (nblk == 256) { for (int l1 = 1; l1 < DEPTH; ++l1) tconv_range(PP, (float*)shm, l1, TC_SPLIT2, TC_L, bid, nblk); }
  lorab_phase(PP, bid, nblk); }
  rope_table_phase(PP, bid);
  { CP p_ = PP; rms_phase<false>(p_->x, p_->norm_g, p_->h, nullptr, bid, nblk); }
  grid.sync();

#pragma unroll 1
  for (int l = 0; l < DEPTH; ++l) {
    REP(1) { CP p_ = PP; EpiProj e{p_->proj}; gemm_phase(lds, p_->h, DM, p_->WtIn + (size_t)l * NP * DM, DM, T, NP, DM, e, bid, nblk); }
    if (l + 1 < DEPTH && nblk == 256 && bid >= 160) tconv_range(PP, (float*)shm, l + 1, 0, TC_SPLIT, bid - 160, 96);
    GSYNC();
    REP(2) for (int u = bid; u < 256; u += nblk) {
      const int e = u >> 7;
      CP p_ = PP;
      EpiLora ep{p_->lw + (size_t)e * T * 1024, p_->w0 + (size_t)(l * 2 + e) * 512, p_->a0 + (size_t)(l * 2 + e) * 512};
      gemm_phase(lds, p_->proj + PIN + e * 256, NP, p_->WtLb + (size_t)(l * 2 + e) * 1024 * 256, 256, T, 1024, 256, ep, u & 127, 128);
    }
    if (nblk < 256) { prep_qkv_phase(PP, l, bid, nblk); prep_vt_phase(PP, bid, nblk); }
    GSYNC();
    if (nblk >= 256) {
      if (bid < 128) { REP(5) scan_item(PP, l, (char*)shm, bid); }
      else {
        REP(2) { prep_qkv_phase(PP, l, bid - 128, nblk - 128); prep_vt_phase(PP, bid - 128, nblk - 128); }
        sub_arrive(kp->bar + XCD_BAR_WORDS);
        REP(4) { prep_a_phase(PP, l, bid - 128, nblk - 128); convd_phase(PP, l, (float*)shm, bid - 128, nblk - 128); }
        sub_wait(kp->bar + XCD_BAR_WORDS, (unsigned)(l + 1) * 128u);
        REP(6) attn_phase(PP, l, (char*)shm, bid - 128, nblk - 128);
        if (l + 1 < DEPTH) tconv_range(PP, (float*)shm, l + 1, TC_SPLIT, TC_SPLIT2, bid - 128, nblk - 128);
      }
    } else {
      for (int it = bid; it < 128; it += nblk) scan_item(PP, l, (char*)shm, it);
      attn_phase(PP, l, (char*)shm, bid, nblk);
      prep_a_phase(PP, l, bid, nblk);
      convd_phase(PP, l, (float*)shm, bid, nblk);
      if (l + 1 < DEPTH) tconv_range(PP, (float*)shm, l + 1, 0, TC_L, bid, nblk);
    }
    GSYNC();
    REP(7) combine_phase(PP, l, bid, nblk);
    GSYNC();
    REP(8) branch_phase(lds, PP, l, bid, nblk);
    GSYNC();
    if ((DUP_MASK >> 10) & 1) GSYNC();
    { CP p_ = PP; EpiOut e{l == 0 ? p_->x : (const float*)p_->xbuf, p_->xbuf}; gemm_phase(lds, p_->mergedb, DM, p_->WtOut + (size_t)l * DM * DM, DM, T, DM, DM, e, bid, nblk); }
    GSYNC();
    if (l < DEPTH - 1) {
      REP(9) { CP p_ = PP; rms_phase<false>(p_->xbuf, p_->norm_g + (size_t)(l + 1) * DM, p_->h, nullptr, bid, nblk); }
      GSYNC();
    } else {
      { CP p_ = PP; rms_phase<true>(p_->xbuf, p_->final_norm_g, nullptr, p_->out, bid, nblk); }
    }
  }
}

extern "C" void kernel_launch(void* const* d_in, const int* in_sizes, int n_in, void* d_out, int out_size, void* d_ws, size_t ws_size, hipStream_t stream) {
  P p{};
  const float** ip = (const float**)&p;
  for (int i = 0; i < 26; ++i) ip[i] = (const float*)d_in[i];
  p.out = (float*)d_out;
  char* w = (char*)d_ws;
  size_t off = 0;
  auto take = [&](size_t bytes) { char* r = w + off; off += (bytes + 255) & ~(size_t)255; return r; };
  p.WtIn = (bf16_t*)take((size_t)DEPTH * NP * DM * 2);
  p.WtBr = (bf16_t*)take((size_t)DEPTH * 4 * DM * BW * 2);
  p.WtOut = (bf16_t*)take((size_t)DEPTH * DM * DM * 2);
  p.WtLb = (bf16_t*)take((size_t)DEPTH * 2 * 1024 * 256 * 2);
  p.h = (bf16_t*)take((size_t)T * DM * 2);
  p.proj = (bf16_t*)take((size_t)T * NP * 2);
  p.qn = (bf16_t*)take((size_t)T * 512 * 2);
  p.kn = (bf16_t*)take((size_t)T * 128 * 2);
  p.vT = (bf16_t*)take((size_t)T * 128 * 2);
  p.ys = (bf16_t*)take((size_t)T * DM * 2);
  p.mergedb = (bf16_t*)take((size_t)T * DM * 2);
  p.lw = (float*)take((size_t)2 * T * 1024 * 4);
  p.SI = (float*)take((size_t)32 * SEQ * 384 * 4);
  p.bonusv = (float*)take((size_t)2 * T * BW * 4);
  p.yraw = (float*)take((size_t)2 * T * BW * 4);
  p.ubuf = (float*)take((size_t)T * BW * 4);
  p.mergedf = (float*)take((size_t)T * DM * 4);
  p.xbuf = (float*)take((size_t)T * DM * 4);
  p.rope = (float*)take((size_t)1024 * 2 * 4);
  p.bar = (unsigned*)take((size_t)(XCD_BAR_WORDS + 64) * 4);
  if (off > ws_size) { fprintf(stderr, "workspace too small: need %zu have %zu\n", off, ws_size); return; }

  static int grid = 0;
  if (!grid) {
    int dev = 0, cus = 0, per_cu = 0;
    (void)hipGetDevice(&dev);
    (void)hipDeviceGetAttribute(&cus, hipDeviceAttributeMultiprocessorCount, dev);
    if (hipFuncSetAttribute((const void*)mega, hipFuncAttributeMaxDynamicSharedMemorySize, GEMM_LDS) != hipSuccess) fprintf(stderr, "hipFuncSetAttribute failed\n");
    if (hipOccupancyMaxActiveBlocksPerMultiprocessor(&per_cu, (const void*)mega, NTH, GEMM_LDS) != hipSuccess || per_cu < 1) { fprintf(stderr, "occupancy query failed (%d)\n", per_cu); per_cu = 1; }
    grid = cus * per_cu;
    if (grid > 256) grid = 256;
  }
  (void)hipMemsetAsync(p.bar, 0, (size_t)(XCD_BAR_WORDS + 64) * 4, stream);
  void* args[] = {&p};
  hipError_t e = hipLaunchCooperativeKernel((const void*)mega, dim3(grid), dim3(NTH), args, GEMM_LDS, stream);
  if (e != hipSuccess) fprintf(stderr, "cooperative launch failed: %s (grid %d)\n", hipGetErrorString(e), grid);
}
```

```cpp
#include <hip/hip_runtime.h>
#include <hip/hip_bf16.h>
#include <stdint.h>
#include <stdio.h>
#include <hip/hip_cooperative_groups.h>
namespace cg = cooperative_groups;

typedef unsigned short bf16_t;
typedef short bf16x8 __attribute__((ext_vector_type(8)));
typedef float f32x4 __attribute__((ext_vector_type(4)));
typedef float f32x2 __attribute__((ext_vector_type(2)));
typedef float f32x16 __attribute__((ext_vector_type(16)));
typedef unsigned u32x4 __attribute__((ext_vector_type(4)));
typedef unsigned u32x2 __attribute__((ext_vector_type(2)));

#define DI __device__ __forceinline__

constexpr int DM = 2048, BATCH = 2, SEQ = 4096, T = BATCH * SEQ, DEPTH = 4, BW = 512;
constexpr int NP = 15616, PIN = 15104;
constexpr int NTH = 512;
constexpr int C_ABG = 0, C_ACG = 512, C_AX = 1024, C_AZ = 1536, C_Q = 2048, C_K = 2560, C_V = 2688, C_BZ = 2816,
              C_CR = 3328, C_CK = 3840, C_CV = 4352, C_CZ = 4864, C_DV = 5376, C_DG = 5888, C_DZ = 6400, C_GATE = 6912;

struct P {
  const float *x, *norm_g, *w_in, *b_gate, *conv_a_w, *q_norm_g, *k_norm_g, *w0, *w_lora_a, *w_lora_b, *a0, *a_lora_a,
      *a_lora_b, *mu_rkv, *k_k, *k_a, *r_k, *gn_g, *gn_b, *dw_w, *dw_b, *ln_g, *ln_b, *w_branch, *w_out, *final_norm_g;
  float* out;
  bf16_t *WtIn, *WtBr, *WtOut, *WtLb, *h, *proj, *qn, *kn, *vT, *ys, *mergedb;
  float *lw, *SI, *bonusv, *yraw, *ubuf, *mergedf, *xbuf;
  float* rope;
  unsigned* bar;
};

typedef const __attribute__((address_space(4))) P* CP;
DI CP launder(CP x) { asm volatile("" : "+s"(x)); return x; }
DI int ltid() { int t = threadIdx.x; asm volatile("" : "+v"(t)); return t; }
DI float bf2f(bf16_t v) { return __uint_as_float(((unsigned)v) << 16); }
DI unsigned pk2(float lo, float hi) {
  typedef __bf16 bf2 __attribute__((ext_vector_type(2)));
  typedef float f2 __attribute__((ext_vector_type(2)));
  f2 v = {lo, hi};
  bf2 r = __builtin_convertvector(v, bf2);
  return __builtin_bit_cast(unsigned, r);
}
DI bf16_t f2bf(float x) { return (bf16_t)(pk2(x, 0.f) & 0xffffu); }
DI float sigmoidf_(float x) { return __builtin_amdgcn_rcpf(1.f + __builtin_amdgcn_exp2f(-1.44269504f * x)); }
DI float tanhf_(float x) { return 1.f - 2.f * __builtin_amdgcn_rcpf(1.f + __builtin_amdgcn_exp2f(2.88539008f * x)); }
DI float siluf_(float x) { return x * sigmoidf_(x); }
DI float wave_sum(float v) {
#pragma unroll
  for (int o = 1; o < 64; o <<= 1) v += __shfl_xor(v, o);
  return v;
}
DI float wave_max(float v) {
#pragma unroll
  for (int o = 1; o < 64; o <<= 1) v = fmaxf(v, __shfl_xor(v, o));
  return v;
}
template <int CTRL> DI float dppf(float x) {
  return __int_as_float(__builtin_amdgcn_update_dpp(0, __float_as_int(x), CTRL, 0xf, 0xf, true));
}
DI float red16(float x) {
  x += dppf<0xB1>(x);
  x += dppf<0x4E>(x);
  x += dppf<0x141>(x);
  x += dppf<0x140>(x);
  return x;
}

DI void tconv_tile(const float* __restrict__ src, int C, int Cv, bf16_t* __restrict__ dst, int ldd, int r0, int c0, float* tile) {
  const int tid = ltid();
  {
    const int tx = tid & 127, ty = tid >> 7;
    const int c = c0 + tx;
    float v[16];
#pragma unroll
    for (int i = 0; i < 16; ++i) v[i] = (c < Cv) ? src[(size_t)(r0 + ty + 4 * i) * C + c] : 0.f;
#pragma unroll
    for (int i = 0; i < 16; ++i) tile[(ty + 4 * i) * 129 + tx] = v[i];
  }
  __syncthreads();
  {
    const int rr = 4 * (tid & 15), cb = tid >> 4;
#pragma unroll
    for (int i = 0; i < 4; ++i) {
      const int cc = cb + 32 * i;
      u32x2 v = {pk2(tile[rr * 129 + cc], tile[(rr + 1) * 129 + cc]), pk2(tile[(rr + 2) * 129 + cc], tile[(rr + 3) * 129 + cc])};
      *(u32x2*)(dst + (size_t)(c0 + cc) * ldd + r0 + rr) = v;
    }
  }
  __syncthreads();
}

constexpr int TC_IN = 118 * 32, TC_LA = 128, TC_OUT = 512, TC_BR = 512, TC_L = TC_IN + TC_LA + TC_OUT + TC_BR, TC_SPLIT = 2304, TC_SPLIT2 = 3840;
DI void tconv_range(CP p, float* tile, int l, int lo, int hi, int bid, int nblk) {
  __syncthreads();
  for (int it = lo + bid; it < hi; it += nblk) {
    int r = it;
    if (r < TC_IN) { tconv_tile(p->w_in + (size_t)l * DM * PIN, PIN, PIN, p->WtIn + (size_t)l * NP * DM, DM, (r / 118) * 64, (r % 118) * 128, tile); continue; }
    r -= TC_IN;
    if (r < TC_LA) {
      const int mtx = r >> 5, tl = r & 31, e = mtx >> 1, isa = mtx & 1;
      const float* src = (isa ? p->a_lora_a : p->w_lora_a) + (size_t)(l * 2 + e) * DM * 96;
      bf16_t* dst = p->WtIn + (size_t)l * NP * DM + (size_t)(PIN + e * 256 + isa * 128) * DM;
      tconv_tile(src, 96, 96, dst, DM, tl * 64, 0, tile);
      continue;
    }
    r -= TC_LA;
    if (r < TC_OUT) { tconv_tile(p->w_out + (size_t)l * DM * DM, DM, DM, p->WtOut + (size_t)l * DM * DM, DM, (r >> 4) * 64, (r & 15) * 128, tile); continue; }
    r -= TC_OUT;
    { const int kb = r >> 7, tl = r & 127;
      tconv_tile(p->w_branch + (size_t)(l * 4 + kb) * BW * DM, DM, DM, p->WtBr + (size_t)(l * 4 + kb) * DM * BW, BW, (tl >> 4) * 64, (tl & 15) * 128, tile); }
  }
}

DI void lorab_phase(CP p, int bid, int nblk) {
  const size_t total = (size_t)DEPTH * 2 * 1024 * 256;
  for (size_t i = (size_t)bid * NTH + ltid(); i < total; i += (size_t)nblk * NTH) {
    const int k = i & 255, n = (i >> 8) & 1023, le = (int)(i >> 18);
    float v = 0.f;
    if (n < 512) { if (k < 96) v = p->w_lora_b[((size_t)le * 96 + k) * 512 + n]; }
    else { if (k >= 128 && k < 224) v = p->a_lora_b[((size_t)le * 96 + (k - 128)) * 512 + (n - 512)]; }
    p->WtLb[i] = f2bf(v);
  }
}

template <bool F32OUT> DI void rms_phase(const float* __restrict__ x, const float* __restrict__ g, bf16_t* hb, float* ho, int bid, int nblk) {
  const int tid_ = ltid(); const int wave = tid_ >> 6, lane = tid_ & 63;
  for (int t = bid * 8 + wave; t < T; t += nblk * 8) {
    const f32x4* xr = (const f32x4*)(x + (size_t)t * DM);
    f32x4 v[8];
    float s = 0.f;
#pragma unroll
    for (int j = 0; j < 8; ++j) { v[j] = xr[lane + 64 * j]; s += v[j].x * v[j].x + v[j].y * v[j].y + v[j].z * v[j].z + v[j].w * v[j].w; }
    s = wave_sum(s);
    const float rstd = rsqrtf(s * (1.f / DM) + 1e-6f);
#pragma unroll
    for (int j = 0; j < 8; ++j) {
      const f32x4 gg = ((const f32x4*)g)[lane + 64 * j];
      f32x4 o = v[j] * rstd * gg;
      if (F32OUT) ((f32x4*)(ho + (size_t)t * DM))[lane + 64 * j] = o;
      else { u32x2 pk = {pk2(o.x, o.y), pk2(o.z, o.w)}; ((u32x2*)(hb + (size_t)t * DM))[lane + 64 * j] = pk; }
    }
  }
}

constexpr int BM = 256, BK = 64, HALF = 128, HT = HALF * BK, GEMM_LDS = 9 * HT * 2, NXCD = 8, WGM = 8;
DI int lds_byte(int r, int c) {
  int st = (r >> 4) * 2 + (c >> 5), rr = r & 15, cc = c & 31, ob = rr * 64 + cc * 2;
  return st * 1024 + (ob ^ (((ob >> 9) & 1) << 5));
}
DI void stage_rc(int b, int& R, int& C) {
  int st = b / 1024, sb = b % 1024, swz = sb ^ (((sb >> 9) & 1) << 5);
  R = (st >> 1) * 16 + swz / 64;
  C = (st & 1) * 32 + (swz % 64) / 2;
}
DI int perm32(int rho) { const int n = rho >> 4, i = rho & 15; return 8 * (i >> 2) + 4 * n + (i & 3); }
DI bool gemm_unit(int L, int nM, int nN, int& pm, int& pn) {
  const int nwg = nM * nN;
  if (L >= nwg) return false;
  int wgid = L;
  { const int q = nwg / NXCD, r = nwg % NXCD, xcd = wgid % NXCD, off = wgid / NXCD; wgid = (xcd < r ? xcd * (q + 1) : r * (q + 1) + (xcd - r) * q) + off; }
  const int nig = WGM * nN, gid = wgid / nig, fm = gid * WGM, gsz = (nM - fm) < WGM ? (nM - fm) : WGM;
  pm = fm + ((wgid % nig) % gsz);
  pn = (wgid % nig) / gsz;
  return true;
}

#define LAS __attribute__((address_space(3)))
template <class Epi>
DI void gemm_phase(LAS unsigned char* lds, const bf16_t* Ag, int lda, const bf16_t* Bg, int ldb, int M, int N, int K, const Epi& E, int bid, int nblk) {
  const int tid = ltid(), wid = __builtin_amdgcn_readfirstlane(tid >> 6), lane = tid & 63, wr = wid >> 2, wc = wid & 3, fr = lane & 15, fq = lane >> 4;
  const int nt = K / BK, nM = M / BM, nN = N / BM;
  unsigned voffA[2], voffB[2];
#pragma unroll
  for (int i = 0; i < 2; ++i) { int R, C; stage_rc(tid * 16 + i * 8192, R, C); const int Rb = Epi::PERM ? ((R & ~31) + perm32(R & 31)) : R; voffA[i] = (unsigned)(R * lda + C) * 2u; voffB[i] = (unsigned)(Rb * ldb + C) * 2u; }
  const size_t kstep = (size_t)(BK * 2);
  const size_t hstepA = (size_t)HALF * lda * 2, hstepB = (size_t)HALF * ldb * 2, tstepA = 2 * hstepA, tstepB = 2 * hstepB;
  const unsigned ldsw = (unsigned)wid * 1024u;
  const int aoff = lds_byte(wr * 64 + fr, fq * 8), boff = lds_byte(wc * 32 + fr, fq * 8);
#define G_SA(b, h) (((b) * 2 + (h)) * (HT * 2))
#define G_SB(b, h) ((4 + (b) * 2 + (h)) * (HT * 2))
#define G_STAGE(bufoff, gbase, voff) do { _Pragma("unroll") for (int _i = 0; _i < 2; ++_i) \
    __builtin_amdgcn_global_load_lds((const unsigned*)((const char*)(gbase) + (voff)[_i]), (LAS unsigned*)(lds + (bufoff) + ldsw + _i * 8192), 16, 0, 0); } while (0)
#define G_LDA(dst, b, h) do { _Pragma("unroll") for (int m = 0; m < 4; ++m) _Pragma("unroll") for (int k = 0; k < 2; ++k) dst[m][k] = *(const LAS bf16x8*)(lds + G_SA(b, h) + aoff + m * 2048 + k * 1024); } while (0)
#define G_LDB(dst, b, h) do { _Pragma("unroll") for (int n = 0; n < 2; ++n) _Pragma("unroll") for (int k = 0; k < 2; ++k) dst[n][k] = *(const LAS bf16x8*)(lds + G_SB(b, h) + boff + n * 2048 + k * 1024); } while (0)
#define G_MMA(ai, bj, At_, Bt_) do { __builtin_amdgcn_s_setprio(1); _Pragma("unroll") for (int m = 0; m < 4; ++m) _Pragma("unroll") for (int n = 0; n < 2; ++n) _Pragma("unroll") for (int k = 0; k < 2; ++k) \
    acc[ai][bj][m][n] = __builtin_amdgcn_mfma_f32_16x16x32_bf16(Bt_[n][k], At_[m][k], acc[ai][bj][m][n], 0, 0, 0); __builtin_amdgcn_s_setprio(0); } while (0)
#define G_WAIT_V(n) asm volatile("s_waitcnt vmcnt(" #n ")" ::: "memory")
#define G_WAIT_L(n) asm volatile("s_waitcnt lgkmcnt(" #n ")" ::: "memory")
#define G_BAR __builtin_amdgcn_s_barrier()
#define G_SCHED __builtin_amdgcn_sched_barrier(0)
  int pm, pn, npm = 0, npn = 0, ui = 0;
  if (!gemm_unit(bid, nM, nN, pm, pn)) return;
  f32x4 acc[2][2][4][2];
#pragma unroll
  for (int a = 0; a < 2; ++a)
#pragma unroll
    for (int b = 0; b < 2; ++b)
#pragma unroll
      for (int m = 0; m < 4; ++m)
#pragma unroll
        for (int n = 0; n < 2; ++n) acc[a][b][m][n] = (f32x4){0.f, 0.f, 0.f, 0.f};
  bf16x8 At[4][2], B0[2][2], B1[2][2];
  const char* cA = (const char*)Ag + (size_t)pm * tstepA;
  const char* cB = (const char*)Bg + (size_t)pn * tstepB;
  G_STAGE(G_SB(0, 0), cB, voffB); G_STAGE(G_SA(0, 0), cA, voffA); G_STAGE(G_SB(0, 1), cB + hstepB, voffB); G_STAGE(G_SA(0, 1), cA + hstepA, voffA);
  if (wr == 1) G_BAR;
  G_WAIT_V(4); G_BAR;
  G_STAGE(G_SB(1, 0), cB + kstep, voffB); G_STAGE(G_SA(1, 0), cA + kstep, voffA); G_STAGE(G_SB(1, 1), cB + hstepB + kstep, voffB);
  G_WAIT_V(6); G_BAR;
  for (;;) {
    const bool has_next = gemm_unit(bid + (ui + 1) * nblk, nM, nN, npm, npn);
    const char* nA = has_next ? (const char*)Ag + (size_t)npm * tstepA : cA;
    const char* nB = has_next ? (const char*)Bg + (size_t)npn * tstepB : cB;
#pragma unroll 1
    for (int t = 0; t < nt; t += 2) {
      const bool last = (t == nt - 2);
      const char* a1 = cA + (size_t)(t + 1) * kstep;
      const char* a2 = last ? nA : cA + (size_t)(t + 2) * kstep;
      const char* b2 = last ? nB : cB + (size_t)(t + 2) * kstep;
      const char* a3 = a2 + kstep;
      const char* b3 = b2 + kstep;
      G_LDB(B0, 0, 0); G_SCHED; G_LDA(At, 0, 0); G_STAGE(G_SA(1, 1), a1 + hstepA, voffA);
      G_WAIT_L(8); G_BAR; G_WAIT_L(0); G_MMA(0, 0, At, B0); G_BAR; G_SCHED;
      G_LDB(B1, 0, 1); G_STAGE(G_SB(0, 0), b2, voffB);
      G_BAR; G_WAIT_L(0); G_MMA(0, 1, At, B1); G_BAR;
      G_LDA(At, 0, 1); G_STAGE(G_SA(0, 0), a2, voffA);
      G_BAR; G_WAIT_L(0); G_MMA(1, 0, At, B0); G_BAR; G_SCHED;
      G_STAGE(G_SB(0, 1), b2 + hstepB, voffB);
      G_WAIT_V(6); G_BAR; G_MMA(1, 1, At, B1); G_BAR;
      G_LDB(B0, 1, 0); G_SCHED; G_LDA(At, 1, 0); G_STAGE(G_SA(0, 1), a2 + hstepA, voffA);
      G_WAIT_L(8); G_BAR; G_WAIT_L(0); G_MMA(0, 0, At, B0); G_BAR; G_SCHED;
      G_LDB(B1, 1, 1); G_STAGE(G_SB(1, 0), b3, voffB);
      G_BAR; G_WAIT_L(0); G_MMA(0, 1, At, B1); G_BAR;
      G_LDA(At, 1, 1); G_STAGE(G_SA(1, 0), a3, voffA);
      G_BAR; G_WAIT_L(0); G_MMA(1, 0, At, B0); G_BAR; G_SCHED;
      G_STAGE(G_SB(1, 1), b3 + hstepB, voffB);
      G_WAIT_V(6); G_BAR; G_MMA(1, 1, At, B1); G_BAR;
    }
    E(acc, pm * BM, pn * BM, wr, wc, fr, fq);
    if (!has_next) break;
#pragma unroll
    for (int a = 0; a < 2; ++a)
#pragma unroll
      for (int b = 0; b < 2; ++b)
#pragma unroll
        for (int m = 0; m < 4; ++m)
#pragma unroll
          for (int n = 0; n < 2; ++n) acc[a][b][m][n] = (f32x4){0.f, 0.f, 0.f, 0.f};
    pm = npm; pn = npn; cA = nA; cB = nB; ++ui;
  }
  G_WAIT_V(0);
  if (wr == 0) G_BAR;
  G_BAR;
#undef G_SA
#undef G_SB
#undef G_STAGE
#undef G_LDA
#undef G_LDB
#undef G_MMA
}

struct EpiProj {
  static constexpr bool PERM = true;
  bf16_t* proj;
  DI void operator()(const f32x4 (&acc)[2][2][4][2], int brow, int bcol, int wr, int wc, int fr, int fq) const {
#pragma unroll
    for (int ai = 0; ai < 2; ++ai)
#pragma unroll
      for (int m = 0; m < 4; ++m) {
        const int row = brow + ai * 128 + wr * 64 + m * 16 + fr;
#pragma unroll
        for (int bj = 0; bj < 2; ++bj) {
          const int col = bcol + bj * 128 + wc * 32 + fq * 8;
          f32x4 v0 = acc[ai][bj][m][0], v1 = acc[ai][bj][m][1];
          if (bcol >= PIN && bj == 0) {
            v0.x = tanhf_(v0.x); v0.y = tanhf_(v0.y); v0.z = tanhf_(v0.z); v0.w = tanhf_(v0.w);
            v1.x = tanhf_(v1.x); v1.y = tanhf_(v1.y); v1.z = tanhf_(v1.z); v1.w = tanhf_(v1.w);
          }
          u32x4 pk = {pk2(v0.x, v0.y), pk2(v0.z, v0.w), pk2(v1.x, v1.y), pk2(v1.z, v1.w)};
          *(u32x4*)(proj + (size_t)row * NP + col) = pk;
        }
      }
  }
};
struct EpiLora {
  static constexpr bool PERM = false;
  float* lw; const float* w0; const float* a0;
  DI void operator()(const f32x4 (&acc)[2][2][4][2], int brow, int bcol, int wr, int wc, int fr, int fq) const {
#pragma unroll
    for (int ai = 0; ai < 2; ++ai)
#pragma unroll
      for (int m = 0; m < 4; ++m) {
        const int row = brow + ai * 128 + wr * 64 + m * 16 + fr;
#pragma unroll
        for (int bj = 0; bj < 2; ++bj)
#pragma unroll
          for (int n = 0; n < 2; ++n) {
            const int col = bcol + bj * 128 + wc * 32 + n * 16 + fq * 4;
            f32x4 v = acc[ai][bj][m][n], o;
            if (col < 512) {
              const f32x4 b = *(const f32x4*)(w0 + col);
#pragma unroll
              for (int j = 0; j < 4; ++j) { const float wl = v[j] + b[j]; o[j] = __expf(-sigmoidf_(wl) * 0.60653066f); }
            } else {
              const f32x4 b = *(const f32x4*)(a0 + col - 512);
#pragma unroll
              for (int j = 0; j < 4; ++j) o[j] = sigmoidf_(v[j] + b[j]);
            }
            *(f32x4*)(lw + (size_t)row * 1024 + col) = o;
          }
      }
  }
};
struct EpiBranch {
  static constexpr bool PERM = false;
  const bf16_t* proj; const float* bg; float* mf; bf16_t* mb; int kb;
  DI void operator()(const f32x4 (&acc)[2][2][4][2], int brow, int bcol, int wr, int wc, int fr, int fq) const {
#pragma unroll
    for (int ai = 0; ai < 2; ++ai)
#pragma unroll
      for (int m = 0; m < 4; ++m) {
        const int row = brow + ai * 128 + wr * 64 + m * 16 + fr;
#pragma unroll
        for (int bj = 0; bj < 2; ++bj)
#pragma unroll
          for (int n = 0; n < 2; ++n) {
            const int col = bcol + bj * 128 + wc * 32 + n * 16 + fq * 4;
            const f32x4 v = acc[ai][bj][m][n];
            const u32x2 gp = *(const u32x2*)(proj + (size_t)row * NP + C_GATE + kb * DM + col);
            const f32x4 b = *(const f32x4*)(bg + col);
            f32x4 o;
            o.x = sigmoidf_(__uint_as_float(gp.x << 16) + b.x) * v.x;
            o.y = sigmoidf_(__uint_as_float(gp.x & 0xffff0000u) + b.y) * v.y;
            o.z = sigmoidf_(__uint_as_float(gp.y << 16) + b.z) * v.z;
            o.w = sigmoidf_(__uint_as_float(gp.y & 0xffff0000u) + b.w) * v.w;
            float* mp = mf + (size_t)row * DM + col;
            if (kb > 0) o += *(const f32x4*)mp;
            if (kb < 3) *(f32x4*)mp = o;
            else { u32x2 pk = {pk2(o.x, o.y), pk2(o.z, o.w)}; *(u32x2*)(mb + (size_t)row * DM + col) = pk; }
          }
      }
  }
};
struct EpiOut {
  static constexpr bool PERM = false;
  const float* xin; float* xout;
  DI void operator()(const f32x4 (&acc)[2][2][4][2], int brow, int bcol, int wr, int wc, int fr, int fq) const {
#pragma unroll
    for (int ai = 0; ai < 2; ++ai)
#pragma unroll
      for (int m = 0; m < 4; ++m) {
        const int row = brow + ai * 128 + wr * 64 + m * 16 + fr;
#pragma unroll
        for (int bj = 0; bj < 2; ++bj)
#pragma unroll
          for (int n = 0; n < 2; ++n) {
            const int col = bcol + bj * 128 + wc * 32 + n * 16 + fq * 4;
            const size_t o = (size_t)row * DM + col;
            *(f32x4*)(xout + o) = *(const f32x4*)(xin + o) + acc[ai][bj][m][n];
          }
      }
  }
};

DI void branch_phase(LAS unsigned char* lds, CP p, int l, int bid, int nblk) {
  const int tid = ltid(), wid = __builtin_amdgcn_readfirstlane(tid >> 6), lane = tid & 63, wr = wid >> 2, wc = wid & 3, fr = lane & 15, fq = lane >> 4;
  unsigned voffA[2], voffB[2];
#pragma unroll
  for (int i = 0; i < 2; ++i) { int R, C; stage_rc(tid * 16 + i * 8192, R, C); const int Rb = (R & ~31) + perm32(R & 31); voffA[i] = (unsigned)(R * DM + C) * 2u; voffB[i] = (unsigned)(Rb * BW + C) * 2u; }
  const unsigned ldsw = (unsigned)wid * 1024u;
  const int aoff = lds_byte(wr * 64 + fr, fq * 8), boff = lds_byte(wc * 32 + fr, fq * 8);
#define BR_STAGE(bufoff, gbase, voff) do { _Pragma("unroll") for (int _i = 0; _i < 2; ++_i) \
    __builtin_amdgcn_global_load_lds((const unsigned*)((const char*)(gbase) + (voff)[_i]), (LAS unsigned*)(lds + (bufoff) + ldsw + _i * 8192), 16, 0, 0); } while (0)
  const bf16_t* ys = p->ys;
  const bf16_t* wbr = p->WtBr + (size_t)l * 4 * DM * BW;
  const bf16_t* proj = p->proj;
  const float* bgp = p->b_gate + (size_t)l * 4 * DM;
  bf16_t* mb = p->mergedb;
#pragma unroll 1
  for (int unit = bid; unit < 512; unit += nblk) {
    int pm, pn;
    if (nblk == 256) { const int bx = unit & 7, bj_ = (unit >> 3) & 31, bi = unit >> 8; pn = bj_ & 7; pm = bi * 32 + bx * 4 + (bj_ >> 3); }
    else { pm = unit >> 3; pn = unit & 7; }
    f32x4 acc[2][4][2], mg[2][4][2];
#pragma unroll
    for (int b = 0; b < 2; ++b)
#pragma unroll
      for (int m = 0; m < 4; ++m)
#pragma unroll
        for (int n = 0; n < 2; ++n) { acc[b][m][n] = (f32x4){0.f, 0.f, 0.f, 0.f}; mg[b][m][n] = (f32x4){0.f, 0.f, 0.f, 0.f}; }
    const char* Ab = (const char*)(ys + (size_t)(pm * 128) * DM);
    const char* Bb = (const char*)(wbr + (size_t)(pn * 256) * BW);
    __syncthreads();
    BR_STAGE(0, Ab, voffA); BR_STAGE(16384, Bb, voffB); BR_STAGE(32768, Bb + (size_t)128 * BW * 2, voffB);
    BR_STAGE(49152, Ab + 128, voffA); BR_STAGE(49152 + 16384, Bb + 128, voffB); BR_STAGE(49152 + 32768, Bb + (size_t)128 * BW * 2 + 128, voffB);
#pragma unroll 1
    for (int q = 0; q < 32; ++q) {
      const int cur = (q % 3) * 49152;
      if (q + 1 < 32) asm volatile("s_waitcnt vmcnt(6)" ::: "memory");
      else asm volatile("s_waitcnt vmcnt(0)" ::: "memory");
      __builtin_amdgcn_s_barrier();
      if (q + 2 < 32) {
        const int q2 = q + 2, kb2 = q2 >> 3, kt2 = q2 & 7, nb = (q2 % 3) * 49152;
        const char* a2 = Ab + (size_t)kb2 * BW * 2 + kt2 * 128;
        const char* b2 = Bb + (size_t)kb2 * DM * BW * 2 + kt2 * 128;
        BR_STAGE(nb, a2, voffA); BR_STAGE(nb + 16384, b2, voffB); BR_STAGE(nb + 32768, b2 + (size_t)128 * BW * 2, voffB);
      }
      bf16x8 At[4][2], Bf[2][2][2];
#pragma unroll
      for (int m = 0; m < 4; ++m)
#pragma unroll
        for (int k = 0; k < 2; ++k) At[m][k] = *(const LAS bf16x8*)(lds + cur + aoff + m * 2048 + k * 1024);
#pragma unroll
      for (int bj = 0; bj < 2; ++bj)
#pragma unroll
        for (int n = 0; n < 2; ++n)
#pragma unroll
          for (int k = 0; k < 2; ++k) Bf[bj][n][k] = *(const LAS bf16x8*)(lds + cur + 16384 + bj * 16384 + boff + n * 2048 + k * 1024);
#pragma unroll
      for (int bj = 0; bj < 2; ++bj)
#pragma unroll
        for (int m = 0; m < 4; ++m)
#pragma unroll
          for (int n = 0; n < 2; ++n)
#pragma unroll
            for (int k = 0; k < 2; ++k) acc[bj][m][n] = __builtin_amdgcn_mfma_f32_16x16x32_bf16(Bf[bj][n][k], At[m][k], acc[bj][m][n], 0, 0, 0);
      if ((q & 7) == 7) {
        const int kb = q >> 3;
#pragma unroll
        for (int m = 0; m < 4; ++m) {
          const int row = pm * 128 + wr * 64 + m * 16 + fr;
#pragma unroll
          for (int bj = 0; bj < 2; ++bj) {
            const int col = pn * 256 + bj * 128 + wc * 32 + fq * 8;
            const u32x4 gp = *(const u32x4*)(proj + (size_t)row * NP + C_GATE + kb * DM + col);
            const f32x4 b0 = *(const f32x4*)(bgp + kb * DM + col), b1 = *(const f32x4*)(bgp + kb * DM + col + 4);
            const f32x4 v0 = acc[bj][m][0], v1 = acc[bj][m][1];
            f32x4 o0, o1;
            o0.x = sigmoidf_(__uint_as_float(gp.x << 16) + b0.x) * v0.x;
            o0.y = sigmoidf_(__uint_as_float(gp.x & 0xffff0000u) + b0.y) * v0.y;
            o0.z = sigmoidf_(__uint_as_float(gp.y << 16) + b0.z) * v0.z;
            o0.w = sigmoidf_(__uint_as_float(gp.y & 0xffff0000u) + b0.w) * v0.w;
            o1.x = sigmoidf_(__uint_as_float(gp.z << 16) + b1.x) * v1.x;
            o1.y = sigmoidf_(__uint_as_float(gp.z & 0xffff0000u) + b1.y) * v1.y;
            o1.z = sigmoidf_(__uint_as_float(gp.w << 16) + b1.z) * v1.z;
            o1.w = sigmoidf_(__uint_as_float(gp.w & 0xffff0000u) + b1.w) * v1.w;
            mg[bj][m][0] += o0; mg[bj][m][1] += o1;
            acc[bj][m][0] = (f32x4){0.f, 0.f, 0.f, 0.f}; acc[bj][m][1] = (f32x4){0.f, 0.f, 0.f, 0.f};
          }
        }
      }
    }
#pragma unroll
    for (int m = 0; m < 4; ++m) {
      const int row = pm * 128 + wr * 64 + m * 16 + fr;
#pragma unroll
      for (int bj = 0; bj < 2; ++bj) {
        const int col = pn * 256 + bj * 128 + wc * 32 + fq * 8;
        const f32x4 o0 = mg[bj][m][0], o1 = mg[bj][m][1];
        u32x4 pk = {pk2(o0.x, o0.y), pk2(o0.z, o0.w), pk2(o1.x, o1.y), pk2(o1.z, o1.w)};
        *(u32x4*)(mb + (size_t)row * DM + col) = pk;
      }
    }
  }
  __syncthreads();
#undef BR_STAGE
}

DI float ldp(const bf16_t* proj, int t, int col) { return bf2f(proj[(size_t)t * NP + col]); }
DI void ld8(const bf16_t* ptr, float (&f)[8]) {
  const u32x4 v = *(const u32x4*)ptr;
  f[0] = __uint_as_float(v.x << 16); f[1] = __uint_as_float(v.x & 0xffff0000u);
  f[2] = __uint_as_float(v.y << 16); f[3] = __uint_as_float(v.y & 0xffff0000u);
  f[4] = __uint_as_float(v.z << 16); f[5] = __uint_as_float(v.z & 0xffff0000u);
  f[6] = __uint_as_float(v.w << 16); f[7] = __uint_as_float(v.w & 0xffff0000u);
}
DI void ld4(const bf16_t* ptr, float (&f)[4]) {
  const u32x2 v = *(const u32x2*)ptr;
  f[0] = __uint_as_float(v.x << 16); f[1] = __uint_as_float(v.x & 0xffff0000u);
  f[2] = __uint_as_float(v.y << 16); f[3] = __uint_as_float(v.y & 0xffff0000u);
}
DI u32x4 pack8(const float (&f)[8]) { u32x4 r = {pk2(f[0], f[1]), pk2(f[2], f[3]), pk2(f[4], f[5]), pk2(f[6], f[7])}; return r; }
DI float red8(float x) {
  x += dppf<0xB1>(x);
  x += dppf<0x4E>(x);
  x += dppf<0x141>(x);
  return x;
}

DI void rope_table_phase(CP p, int bid) {
  if (bid != 0) return;
  for (int i = ltid(); i < 1024; i += NTH) {
    const int pos = i >> 4, pi = i & 15;
    const float inv = exp2f(-(float)pi * (13.287712379549449f / 16.f));
    float sn, cs;
    sincosf((float)pos * inv, &sn, &cs);
    p->rope[2 * i] = cs;
    p->rope[2 * i + 1] = sn;
  }
}

DI void prep_a_phase(CP p, int l, int bid, int nblk) {
  const float* cw = p->conv_a_w + (size_t)l * 3 * BW;
  for (int i = bid * NTH + ltid(); i < T * 64; i += nblk * NTH) {
    const int c = (i & 63) * 8, t = i >> 6, s = t & (SEQ - 1);
    const bf16_t* row = p->proj + (size_t)t * NP;
    float cg[8], ax[8], u0[8], um[8], up[8], bg[8], az[8], o[8];
    ld8(row + C_ACG + c, cg); ld8(row + C_AX + c, ax);
#pragma unroll
    for (int k = 0; k < 8; ++k) { u0[k] = cg[k] * ax[k]; um[k] = 0.f; up[k] = 0.f; }
    if (s > 0) {
      ld8(row - NP + C_ACG + c, cg); ld8(row - NP + C_AX + c, ax);
#pragma unroll
      for (int k = 0; k < 8; ++k) um[k] = cg[k] * ax[k];
    }
    if (s < SEQ - 1) {
      ld8(row + NP + C_ACG + c, cg); ld8(row + NP + C_AX + c, ax);
#pragma unroll
      for (int k = 0; k < 8; ++k) up[k] = cg[k] * ax[k];
    }
    ld8(row + C_ABG + c, bg); ld8(row + C_AZ + c, az);
    const f32x4 w0a = *(const f32x4*)(cw + c), w0b = *(const f32x4*)(cw + c + 4), w1a = *(const f32x4*)(cw + BW + c), w1b = *(const f32x4*)(cw + BW + c + 4),
                w2a = *(const f32x4*)(cw + 2 * BW + c), w2b = *(const f32x4*)(cw + 2 * BW + c + 4);
#pragma unroll
    for (int k = 0; k < 8; ++k) {
      const float w0 = k < 4 ? w0a[k & 3] : w0b[k & 3], w1 = k < 4 ? w1a[k & 3] : w1b[k & 3], w2 = k < 4 ? w2a[k & 3] : w2b[k & 3];
      o[k] = bg[k] * (w0 * um[k] + w1 * u0[k] + w2 * up[k]) * siluf_(az[k]);
    }
    *(u32x4*)(p->ys + (size_t)t * DM + c) = pack8(o);
  }
}

DI void prep_qkv_phase(CP p, int l, int bid, int nblk) {
  const int tid = ltid(), wave = tid >> 6, lane = tid & 63, rsub = lane >> 3, chunk = lane & 7;
  const f32x4 gqa = *(const f32x4*)(p->q_norm_g + l * 64 + chunk * 8), gqb = *(const f32x4*)(p->q_norm_g + l * 64 + chunk * 8 + 4);
  const f32x4 gka = *(const f32x4*)(p->k_norm_g + l * 64 + chunk * 8), gkb = *(const f32x4*)(p->k_norm_g + l * 64 + chunk * 8 + 4);
  const int half = chunk >> 2, pbase = (chunk & 1) * 8;
  const bool second = (chunk & 2) != 0;
  for (int wi = bid * 8 + wave; wi < T * 10 / 8; wi += nblk * 8) {
    const int ri = wi * 8 + rsub, t = ri / 10, slot = ri % 10, s = t & (SEQ - 1);
    const int col = slot < 8 ? (C_Q + slot * 64) : (C_K + (slot - 8) * 64);
    float x[8], o[8];
    ld8(p->proj + (size_t)t * NP + col + chunk * 8, x);
    float ss = 0.f;
#pragma unroll
    for (int k = 0; k < 8; ++k) ss += x[k] * x[k];
    ss = red8(ss);
    const float rs = rsqrtf(ss * (1.f / 64.f) + 1e-6f);
    const int pos = half ? (s & 63) : (s >> 6);
    const f32x4* tb = (const f32x4*)(p->rope + (size_t)(pos * 16 + pbase) * 2);
    const f32x4 cs0 = tb[0], cs1 = tb[1], cs2 = tb[2], cs3 = tb[3];
#pragma unroll
    for (int k = 0; k < 8; ++k) {
      const float gq = k < 4 ? gqa[k & 3] : gqb[k & 3], gk = k < 4 ? gka[k & 3] : gkb[k & 3];
      const float xn = x[k] * rs * (slot < 8 ? gq : gk);
      const float other = dppf<0x4E>(xn);
      const f32x4 cs = (k >> 1) == 0 ? cs0 : ((k >> 1) == 1 ? cs1 : ((k >> 1) == 2 ? cs2 : cs3));
      const float cv = cs[(k & 1) * 2], sv = cs[(k & 1) * 2 + 1];
      o[k] = (second ? (xn * cv + other * sv) : (xn * cv - other * sv)) * (slot < 8 ? 0.18033688f : 1.f);
    }
    bf16_t* dst = slot < 8 ? (p->qn + (size_t)t * 512 + slot * 64 + chunk * 8) : (p->kn + (size_t)t * 128 + (slot - 8) * 64 + chunk * 8);
    *(u32x4*)dst = pack8(o);
  }
}

DI void prep_vt_phase(CP p, int bid, int nblk) {
  for (int i = bid * NTH + ltid(); i < (T / 8) * 16; i += nblk * NTH) {
    const int chunk = i & 7, kvh = (i >> 3) & 1, tg = i >> 4;
    const int t0 = tg * 8, b = t0 / SEQ, s0 = t0 & (SEQ - 1);
    u32x4 in[8];
#pragma unroll
    for (int r = 0; r < 8; ++r) in[r] = *(const u32x4*)(p->proj + (size_t)(t0 + r) * NP + C_V + kvh * 64 + chunk * 8);
#pragma unroll
    for (int k = 0; k < 8; ++k) {
      unsigned e[8];
#pragma unroll
      for (int r = 0; r < 8; ++r) { const unsigned w = in[r][k >> 1]; e[r] = (k & 1) ? (w >> 16) : (w & 0xffffu); }
      u32x4 o = {e[0] | (e[1] << 16), e[2] | (e[3] << 16), e[4] | (e[5] << 16), e[6] | (e[7] << 16)};
      *(u32x4*)(p->vT + ((size_t)((b * 2 + kvh) * 64 + chunk * 8 + k)) * SEQ + s0) = o;
    }
  }
}

DI void prep_rwkv_phase(CP p, int l, int bid, int nblk) {
  const int tid = ltid(), wave = tid >> 6, lane = tid & 63, sub = lane >> 4, kq = lane & 15;
  for (int wi = bid * 8 + wave; wi < T * 2; wi += nblk * 8) {
    const int it = wi * 4 + sub, h = it & 7, t = it >> 3, s = t & (SEQ - 1), b = t / SEQ, c = h * 64 + kq * 4;
    const bf16_t* row = p->proj + (size_t)t * NP;
    float rc[4], kc[4], vc[4];
    ld4(row + C_CR + c, rc); ld4(row + C_CK + c, kc); ld4(row + C_CV + c, vc);
    const f32x4 kkp = *(const f32x4*)(p->k_k + l * BW + c), kap = *(const f32x4*)(p->k_a + l * BW + c), rkp = *(const f32x4*)(p->r_k + l * BW + c);
#pragma unroll
    for (int e = 0; e < 2; ++e) {
      const bool valid = e ? (s < SEQ - 1) : (s > 0);
      const bf16_t* prow = e ? (row + NP) : (row - NP);
      float rp[4] = {0.f, 0.f, 0.f, 0.f}, kp[4] = {0.f, 0.f, 0.f, 0.f}, vp[4] = {0.f, 0.f, 0.f, 0.f};
      if (valid) { ld4(prow + C_CR + c, rp); ld4(prow + C_CK + c, kp); ld4(prow + C_CV + c, vp); }
      const float* mu = p->mu_rkv + (size_t)(l * 2 + e) * 3 * BW + c;
      const f32x4 mur = *(const f32x4*)mu, muk = *(const f32x4*)(mu + BW), muv = *(const f32x4*)(mu + 2 * BW);
      const float* lwp = p->lw + ((size_t)e * T + t) * 1024 + c;
      const f32x4 dec = *(const f32x4*)lwp, a = *(const f32x4*)(lwp + 512);
      f32x4 r2, k2, v2, kk, kt;
      float n2 = 0.f;
#pragma unroll
      for (int i = 0; i < 4; ++i) {
        r2[i] = rc[i] + (rp[i] - rc[i]) * mur[i];
        k2[i] = kc[i] + (kp[i] - kc[i]) * muk[i];
        v2[i] = vc[i] + (vp[i] - vc[i]) * muv[i];
        kk[i] = k2[i] * kkp[i];
        n2 += kk[i] * kk[i];
        kt[i] = k2[i] * (1.f + (a[i] - 1.f) * kap[i]);
      }
      n2 = red16(n2);
      const float rn = 1.f / fmaxf(sqrtf(n2), 1e-12f);
      float bs = 0.f;
#pragma unroll
      for (int i = 0; i < 4; ++i) { kk[i] *= rn; bs += r2[i] * kt[i] * rkp[i]; }
      bs = red16(bs);
      *(f32x4*)(p->bonusv + ((size_t)e * T + t) * BW + c) = v2 * bs;
      const int j = e ? (SEQ - 1 - s) : s;
      float* si = p->SI + (((size_t)((e * 2 + b) * 8 + h)) * SEQ + j) * 384 + kq * 4;
      *(f32x4*)(si) = r2;
      *(f32x4*)(si + 64) = dec;
      *(f32x4*)(si + 128) = kt;
      *(f32x4*)(si + 192) = -kk;
      *(f32x4*)(si + 256) = kk * a;
      *(f32x4*)(si + 320) = v2;
    }
  }
}

DI void convd_phase(CP p, int l, float* lds, int bid, int nblk) {
  const int c = ltid(), wave = c >> 6, lane = c & 63;
  const float* dw = p->dw_w + (size_t)l * 31 * BW;
  float wreg[31];
#pragma unroll
  for (int j = 0; j < 31; ++j) wreg[j] = dw[j * BW + c];
  const float bias = p->dw_b[l * BW + c], lg = p->ln_g[l * BW + c], lb = p->ln_b[l * BW + c];
  float* tr = lds;
  float* st = lds + 32 * 512;
  for (int blk = bid; blk < T / 32; blk += nblk) {
    const int t0 = blk * 32, s0 = t0 & (SEQ - 1);
    float u[62];
#pragma unroll
    for (int i = 0; i < 62; ++i) {
      const int s = s0 - 15 + i;
      u[i] = 0.f;
      if (s >= 0 && s < SEQ) {
        const bf16_t* row = p->proj + (size_t)(t0 - 15 + i) * NP;
        u[i] = bf2f(row[C_DV + c]) * sigmoidf_(bf2f(row[C_DG + c]));
      }
    }
    float acc[32];
    __syncthreads();
#pragma unroll
    for (int tk = 0; tk < 32; ++tk) {
      float a = bias;
#pragma unroll
      for (int j = 0; j < 31; ++j) a += wreg[j] * u[tk + j];
      acc[tk] = a;
      tr[tk * 512 + c] = a;
    }
    __syncthreads();
#pragma unroll
    for (int q = 0; q < 4; ++q) {
      const int tk = wave * 4 + q;
      float xv[8], sm = 0.f;
#pragma unroll
      for (int i = 0; i < 8; ++i) { xv[i] = tr[tk * 512 + lane + 64 * i]; sm += xv[i]; }
      const float mean = wave_sum(sm) * (1.f / BW);
      float sq = 0.f;
#pragma unroll
      for (int i = 0; i < 8; ++i) { const float d = xv[i] - mean; sq += d * d; }
      const float var = wave_sum(sq) * (1.f / BW);
      if (lane == 0) { st[tk * 2] = mean; st[tk * 2 + 1] = rsqrtf(var + 1e-5f); }
    }
    __syncthreads();
#pragma unroll
    for (int tk = 0; tk < 32; ++tk) {
      const float mean = st[tk * 2], rstd = st[tk * 2 + 1];
      const float un = (acc[tk] - mean) * rstd * lg + lb;
      const float yd = siluf_(un) * siluf_(ldp(p->proj, t0 + tk, C_DZ + c));
      p->ys[(size_t)(t0 + tk) * DM + 3 * BW + c] = f2bf(yd);
    }
  }
}

#define MFMA32(a, b, c) __builtin_amdgcn_mfma_f32_32x32x16_bf16((a), (b), (c), 0, 0, 0)
DI void attn_phase(CP p, int l, char* smem, int bid, int nblk) {
  const int tid = ltid(), wave = tid >> 6, lane = tid & 63, r = lane & 31, hh = lane >> 5;
  const float gq = wave_max(fabsf(p->q_norm_g[l * 64 + lane])), gk = wave_max(fabsf(p->k_norm_g[l * 64 + lane]));
  const float Mb = 8.f * gq * gk * 1.0001f;
  const float c2 = Mb * 1.44269504f;
  const int row = tid >> 3, c16 = tid & 7;
  const int woff = row * 128 + ((c16 ^ ((row >> 1) & 7)) << 4);
  for (int item = bid; item < 256; item += nblk) {
    const int b = item >> 7, head = (item >> 4) & 7, qt = item & 15, kvh = head >> 2;
    const int t0 = b * SEQ + qt * 256 + wave * 32;
    bf16x8 qf[4];
#pragma unroll
    for (int s = 0; s < 4; ++s) qf[s] = *(const bf16x8*)(p->qn + (size_t)(t0 + r) * 512 + head * 64 + 16 * s + 8 * hh);
    f32x16 o0, o1;
#pragma unroll
    for (int i = 0; i < 16; ++i) { o0[i] = 0.f; o1[i] = 0.f; }
    f32x2 lsum2 = {0.f, 0.f};
    f32x16 negc2v;
#pragma unroll
    for (int i = 0; i < 16; ++i) negc2v[i] = -c2;
    const bf16_t* kbase = p->kn + (size_t)(b * SEQ) * 128 + kvh * 64;
    const bf16_t* vbase = p->vT + (size_t)((b * 2 + kvh) * 64) * SEQ;
    u32x4 kreg = *(const u32x4*)(kbase + (size_t)row * 128 + c16 * 8);
    u32x4 vreg = *(const u32x4*)(vbase + (size_t)row * SEQ + c16 * 8);
    __syncthreads();
    *(u32x4*)(smem + woff) = kreg;
    *(u32x4*)(smem + 16384 + woff) = vreg;
    __syncthreads();
#pragma unroll 1
    for (int kt = 0; kt < 64; ++kt) {
      const int cur = kt & 1;
      if (kt + 1 < 64) {
        kreg = *(const u32x4*)(kbase + (size_t)((kt + 1) * 64 + row) * 128 + c16 * 8);
        vreg = *(const u32x4*)(vbase + (size_t)row * SEQ + (kt + 1) * 64 + c16 * 8);
      }
      const char* kb_ = smem + cur * 8192;
      const char* vb_ = smem + 16384 + cur * 8192;
#pragma unroll
      for (int kb = 0; kb < 2; ++kb) {
        f32x16 sacc = negc2v;
        const int krow_ = kb * 32 + r;
#pragma unroll
        for (int s = 0; s < 4; ++s) {
          const int c = 2 * s + hh;
          const bf16x8 kf = *(const bf16x8*)(kb_ + krow_ * 128 + ((c ^ ((krow_ >> 1) & 7)) << 4));
          sacc = MFMA32(kf, qf[s], sacc);
        }
        float pv[16];
#pragma unroll
        for (int i = 0; i < 16; ++i) pv[i] = __builtin_amdgcn_exp2f(sacc[i]);
#pragma unroll
        for (int i = 0; i < 16; i += 2) { const f32x2 pp2 = {pv[i], pv[i + 1]}; lsum2 += pp2; }
#pragma unroll
        for (int s2 = 0; s2 < 2; ++s2) {
          u32x4 pp = {pk2(pv[8 * s2], pv[8 * s2 + 1]), pk2(pv[8 * s2 + 2], pv[8 * s2 + 3]), pk2(pv[8 * s2 + 4], pv[8 * s2 + 5]), pk2(pv[8 * s2 + 6], pv[8 * s2 + 7])};
          const bf16x8 pf = __builtin_bit_cast(bf16x8, pp);
          const int cA = kb * 4 + 2 * s2;
#pragma unroll
          for (int dblk = 0; dblk < 2; ++dblk) {
            const int drow = dblk * 32 + r;
            const int sw = (drow >> 1) & 7;
            const u32x2 lo = *(const u32x2*)(vb_ + drow * 128 + ((cA ^ sw) << 4) + 8 * hh);
            const u32x2 hi = *(const u32x2*)(vb_ + drow * 128 + (((cA + 1) ^ sw) << 4) + 8 * hh);
            u32x4 vv = {lo.x, lo.y, hi.x, hi.y};
            const bf16x8 vf = __builtin_bit_cast(bf16x8, vv);
            if (dblk == 0) o0 = MFMA32(vf, pf, o0); else o1 = MFMA32(vf, pf, o1);
          }
        }
      }
      if (kt + 1 < 64) {
        *(u32x4*)(smem + (cur ^ 1) * 8192 + woff) = kreg;
        *(u32x4*)(smem + 16384 + (cur ^ 1) * 8192 + woff) = vreg;
      }
      __syncthreads();
    }
    const float lsum = lsum2.x + lsum2.y;
    const float ltot = lsum + __shfl_xor(lsum, 32);
    const float linv = 1.f / ltot;
    const int t = t0 + r;
#pragma unroll
    for (int dblk = 0; dblk < 2; ++dblk)
#pragma unroll
      for (int g = 0; g < 4; ++g) {
        const int d0 = dblk * 32 + 8 * g + 4 * hh;
        const u32x2 zp = *(const u32x2*)(p->proj + (size_t)t * NP + C_BZ + head * 64 + d0);
        float z[4] = {__uint_as_float(zp.x << 16), __uint_as_float(zp.x & 0xffff0000u), __uint_as_float(zp.y << 16), __uint_as_float(zp.y & 0xffff0000u)};
        float ov[4];
#pragma unroll
        for (int j = 0; j < 4; ++j) ov[j] = ((dblk == 0) ? o0[4 * g + j] : o1[4 * g + j]) * linv * siluf_(z[j]);
        u32x2 pk = {pk2(ov[0], ov[1]), pk2(ov[2], ov[3])};
        *(u32x2*)(p->ys + (size_t)t * DM + BW + head * 64 + d0) = pk;
      }
  }
}

#define LDS_BARRIER() asm volatile("s_waitcnt lgkmcnt(0)\n\ts_barrier" ::: "memory")
DI void scan_item(CP p, int l, char* smem, int item) {
  const int tid = ltid(), wave = tid >> 6, lane = tid & 63, kq = lane & 15, rw = lane >> 4;
  const int x = item & 7, jx = item >> 3;
  const int chain = x * 4 + (jx >> 2), quarter = jx & 3;
  const int e = chain >> 4, b = (chain >> 3) & 1, h = chain & 7;
  const float* si = p->SI + (size_t)chain * SEQ * 384;
  constexpr int CH = 32, NCH = SEQ / CH;
  __syncthreads();
  if (wave >= 4) {
    const int g = (tid - 256) >> 4, c4 = h * 64 + kq * 4;
    const f32x4 kkp = *(const f32x4*)(p->k_k + l * BW + c4), kap = *(const f32x4*)(p->k_a + l * BW + c4), rkp = *(const f32x4*)(p->r_k + l * BW + c4);
    const float* mu = p->mu_rkv + (size_t)(l * 2 + e) * 3 * BW + c4;
    const f32x4 mur = *(const f32x4*)mu, muk = *(const f32x4*)(mu + BW), muv = *(const f32x4*)(mu + 2 * BW);
    const bf16_t* projb = p->proj;
    const float* lwb = p->lw + (size_t)e * T * 1024;
    float* bonb = p->bonusv + (size_t)e * T * BW;
    u32x2 in_c[2][3], in_p[2][3];
    f32x4 in_d[2], in_a[2];
#define SC_LOAD(CI) do { _Pragma("unroll") for (int ps = 0; ps < 2; ++ps) { \
      const int j_ = (CI) * CH + ps * 16 + g; const int s_ = e ? (SEQ - 1 - j_) : j_; const int t_ = b * SEQ + s_; \
      const bool valid_ = e ? (s_ < SEQ - 1) : (s_ > 0); \
      const bf16_t* row_ = projb + (size_t)t_ * NP + c4; const bf16_t* prow_ = valid_ ? (e ? row_ + NP : row_ - NP) : row_; \
      in_c[ps][0] = *(const u32x2*)(row_ + C_CR); in_c[ps][1] = *(const u32x2*)(row_ + C_CK); in_c[ps][2] = *(const u32x2*)(row_ + C_CV); \
      in_p[ps][0] = *(const u32x2*)(prow_ + C_CR); in_p[ps][1] = *(const u32x2*)(prow_ + C_CK); in_p[ps][2] = *(const u32x2*)(prow_ + C_CV); \
      const float* lw_ = lwb + (size_t)t_ * 1024 + c4; in_d[ps] = *(const f32x4*)lw_; in_a[ps] = *(const f32x4*)(lw_ + 512); } } while (0)
#define SC_UNPK(U, F) do { F[0] = __uint_as_float(U.x << 16); F[1] = __uint_as_float(U.x & 0xffff0000u); F[2] = __uint_as_float(U.y << 16); F[3] = __uint_as_float(U.y & 0xffff0000u); } while (0)
#define SC_BUILD(CI, BUF) do { _Pragma("unroll") for (int ps = 0; ps < 2; ++ps) { \
      const int j_ = (CI) * CH + ps * 16 + g; const int s_ = e ? (SEQ - 1 - j_) : j_; const int t_ = b * SEQ + s_; \
      const bool valid_ = e ? (s_ < SEQ - 1) : (s_ > 0); \
      float rc[4], kc[4], vc[4], rp[4], kp[4], vp[4]; \
      SC_UNPK(in_c[ps][0], rc); SC_UNPK(in_c[ps][1], kc); SC_UNPK(in_c[ps][2], vc); SC_UNPK(in_p[ps][0], rp); SC_UNPK(in_p[ps][1], kp); SC_UNPK(in_p[ps][2], vp); \
      const f32x4 dec = in_d[ps], a = in_a[ps]; \
      f32x4 r2, k2, v2, kk, kt; float n2 = 0.f; \
      _Pragma("unroll") for (int i = 0; i < 4; ++i) { \
        const float rpi = valid_ ? rp[i] : 0.f, kpi = valid_ ? kp[i] : 0.f, vpi = valid_ ? vp[i] : 0.f; \
        r2[i] = rc[i] + (rpi - rc[i]) * mur[i]; k2[i] = kc[i] + (kpi - kc[i]) * muk[i]; v2[i] = vc[i] + (vpi - vc[i]) * muv[i]; \
        kk[i] = k2[i] * kkp[i]; n2 += kk[i] * kk[i]; kt[i] = k2[i] * (1.f + (a[i] - 1.f) * kap[i]); } \
      n2 = red16(n2); const float rn = 1.f / fmaxf(sqrtf(n2), 1e-12f); float bs = 0.f; \
      _Pragma("unroll") for (int i = 0; i < 4; ++i) { kk[i] *= rn; bs += r2[i] * kt[i] * rkp[i]; } \
      bs = red16(bs); \
      if (quarter == 0) *(f32x4*)(bonb + (size_t)t_ * BW + c4) = v2 * bs; \
      float* so_ = (float*)((BUF) + (ps * 16 + g) * 1536) + kq * 4; \
      *(f32x4*)(so_) = r2; *(f32x4*)(so_ + 64) = dec; *(f32x4*)(so_ + 128) = kt; *(f32x4*)(so_ + 192) = -kk; *(f32x4*)(so_ + 256) = kk * a; *(f32x4*)(so_ + 320) = v2; } } while (0)
    SC_LOAD(0);
    SC_BUILD(0, smem);
    SC_LOAD(1);
    LDS_BARRIER();
#pragma unroll 1
    for (int c = 0; c < NCH; ++c) {
      if (c + 1 < NCH) SC_BUILD(c + 1, smem + ((c + 1) & 1) * 49152);
      if (c + 2 < NCH) SC_LOAD(c + 2);
      LDS_BARRIER();
    }
#undef SC_LOAD
#undef SC_UNPK
#undef SC_BUILD
  } else {
    __builtin_amdgcn_s_setprio(3);
    const int v = quarter * 16 + wave * 4 + rw;
    f32x2 sA = {0.f, 0.f}, sB = {0.f, 0.f};
    float* yout = p->yraw + ((size_t)e * T + (size_t)b * SEQ) * BW + h * 64 + v;
    LDS_BARRIER();
#pragma unroll 1
    for (int c = 0; c < NCH; ++c) {
      const float* sb = (const float*)(smem + (c & 1) * 49152);
      {
        float ykeep = 0.f;
#define LD_STEP(R4, W4, KT4, KN4, BB4, VV, STP) do { const float* st_ = (STP); R4 = *(const f32x4*)(st_ + kq * 4); W4 = *(const f32x4*)(st_ + 64 + kq * 4); \
          KT4 = *(const f32x4*)(st_ + 128 + kq * 4); KN4 = *(const f32x4*)(st_ + 192 + kq * 4); BB4 = *(const f32x4*)(st_ + 256 + kq * 4); VV = st_[320 + v]; } while (0)
        f32x4 r4, w4, kt4, kn4, bb4, r4b, w4b, kt4b, kn4b, bb4b;
        float vv, vvb;
        LD_STEP(r4, w4, kt4, kn4, bb4, vv, sb);
        LD_STEP(r4b, w4b, kt4b, kn4b, bb4b, vvb, sb + 384);
#pragma unroll
        for (int jj = 0; jj < 32; ++jj) {
          f32x4 r4c = r4b, w4c = w4b, kt4c = kt4b, kn4c = kn4b, bb4c = bb4b;
          float vvc = vvb;
          if (jj + 2 < 32) LD_STEP(r4c, w4c, kt4c, kn4c, bb4c, vvc, sb + (jj + 2) * 384);
          const f32x2 knA = {kn4.x, kn4.y}, knB = {kn4.z, kn4.w}, wA = {w4.x, w4.y}, wB = {w4.z, w4.w}, ktA = {kt4.x, kt4.y}, ktB = {kt4.z, kt4.w},
                      bbA = {bb4.x, bb4.y}, bbB = {bb4.z, bb4.w}, rA = {r4.x, r4.y}, rB = {r4.z, r4.w};
          f32x2 t = sA * knA;
          t = sB * knB + t;
          const float sa = red16(t.x + t.y);
          const f32x2 vv2 = {vv, vv};
          const f32x2 mA = sA * wA + vv2 * ktA, mB = sB * wB + vv2 * ktB;
          const f32x2 sa2 = {sa, sa};
          sA = sa2 * bbA + mA;
          sB = sa2 * bbB + mB;
          f32x2 ty = sA * rA;
          ty = sB * rB + ty;
          const float y = red16(ty.x + ty.y);
          ykeep = (kq == (jj & 15)) ? y : ykeep;
          if ((jj & 15) == 15) {
            const int j = c * CH + (jj & 16) + kq;
            const int so = e ? (SEQ - 1 - j) : j;
            yout[(size_t)so * BW] = ykeep;
          }
          r4 = r4b; w4 = w4b; kt4 = kt4b; kn4 = kn4b; bb4 = bb4b; vv = vvb;
          r4b = r4c; w4b = w4c; kt4b = kt4c; kn4b = kn4c; bb4b = bb4c; vvb = vvc;
        }
#undef LD_STEP
      }
      LDS_BARRIER();
    }
    __builtin_amdgcn_s_setprio(0);
  }
}

DI void combine_phase(CP p, int l, int bid, int nblk) {
  const int tid = ltid(), wave = tid >> 6, lane = tid & 63, sub = lane >> 4, kq = lane & 15;
  for (int wi = bid * 8 + wave; wi < T * 2; wi += nblk * 8) {
    const int it = wi * 4 + sub, h = it & 7, t = it >> 3, c = h * 64 + kq * 4;
    const f32x4 g = *(const f32x4*)(p->gn_g + l * BW + c), gb = *(const f32x4*)(p->gn_b + l * BW + c);
    f32x4 tot = {0.f, 0.f, 0.f, 0.f};
#pragma unroll
    for (int e = 0; e < 2; ++e) {
      const f32x4 y = *(const f32x4*)(p->yraw + ((size_t)e * T + t) * BW + c);
      const float mean = red16(y.x + y.y + y.z + y.w) * (1.f / 64.f);
      const f32x4 d = y - mean;
      const float var = red16(d.x * d.x + d.y * d.y + d.z * d.z + d.w * d.w) * (1.f / 64.f);
      const float rstd = rsqrtf(var + 64e-5f);
      tot += d * rstd * g + gb + *(const f32x4*)(p->bonusv + ((size_t)e * T + t) * BW + c);
    }
    float z[4];
    ld4(p->proj + (size_t)t * NP + C_CZ + c, z);
    u32x2 pk = {pk2(tot.x * siluf_(z[0]), tot.y * siluf_(z[1])), pk2(tot.z * siluf_(z[2]), tot.w * siluf_(z[3]))};
    *(u32x2*)(p->ys + (size_t)t * DM + 2 * BW + c) = pk;
  }
}

#define XB_TMO      128
#define XB_XCNT(j)  (256  + 64 * (j))
#define XB_XSUB(j)  (1280 + 64 * (j))
#define XB_XGEN(j)  (2304 + 64 * (j))
#define XB_TOP      3328
#define XB_TOPGEN   3392
#define XCD_BAR_WORDS 3456
#define XB_SPIN_CAP (1u << 18)
DI unsigned xb_ld(unsigned* p) { return __hip_atomic_load(p, __ATOMIC_RELAXED, __HIP_MEMORY_SCOPE_AGENT); }
DI unsigned xb_add(unsigned* p, unsigned v) { return __hip_atomic_fetch_add(p, v, __ATOMIC_RELAXED, __HIP_MEMORY_SCOPE_AGENT); }
DI unsigned xb_xcc_id() { return (unsigned)__builtin_amdgcn_s_getreg((3 << 11) | 20) & 0xFu; }
#define XB_SPIN(cond, bar) do { unsigned _sp = 0; while (cond) { __builtin_amdgcn_s_sleep(1); \
    if ((++_sp & 255u) == 0u) { if (xb_ld(&(bar)[XB_TMO])) break; if (_sp > XB_SPIN_CAP) { atomicAdd(&(bar)[XB_TMO], 1u); break; } } } } while (0)
struct XcdBarrier { unsigned* bar; unsigned x; volatile LAS unsigned* st; };
DI XcdBarrier xcd_barrier_post(unsigned* bar, volatile LAS unsigned* st) {
  XcdBarrier b; b.bar = bar; b.x = xb_xcc_id(); b.st = st;
  if (threadIdx.x == 0) (void)xb_add(&bar[XB_XCNT(b.x)], 1u);
  return b;
}
DI void xcd_barrier_complete(unsigned* bar, unsigned x, unsigned& nloc, unsigned& nx) {
  const unsigned G = gridDim.x * gridDim.y * gridDim.z;
  unsigned sum, cnt, mine, sp = 0u;
  for (;;) {
    sum = 0u; cnt = 0u; mine = 0u;
#pragma unroll
    for (unsigned j = 0; j < 16; ++j) { const unsigned c = xb_ld(&bar[XB_XCNT(j)]); sum += c; cnt += (c > 0u) ? 1u : 0u; mine = (j == x) ? c : mine; }
    if (sum == G) break;
    __builtin_amdgcn_s_sleep(1);
    if ((++sp & 255u) == 0u) { if (xb_ld(&bar[XB_TMO])) break; if (sp > XB_SPIN_CAP) { atomicAdd(&bar[XB_TMO], 1u); break; } }
  }
  nloc = mine > 0u ? mine : 1u; nx = cnt > 0u ? cnt : 1u;
}
DI void xcd_barrier(const XcdBarrier& b) {
  asm volatile("s_waitcnt vmcnt(0)" ::: "memory");
  __syncthreads();
  if (threadIdx.x == 0) {
    unsigned* bar = b.bar;
    __builtin_amdgcn_s_waitcnt(0);
    unsigned nloc = b.st[0], nx = b.st[1];
    if (nloc == 0u) { xcd_barrier_complete(bar, b.x, nloc, nx); b.st[0] = nloc; b.st[1] = nx; }
    const unsigned old = xb_add(&bar[XB_XSUB(b.x)], 1u);
    const unsigned gen = old / nloc;
    if (old + 1u == (gen + 1u) * nloc) {
      __builtin_amdgcn_fence(__ATOMIC_RELEASE, "agent");
      asm volatile("s_waitcnt vmcnt(0)" ::: "memory");
      const unsigned og = xb_add(&bar[XB_TOP], 1u);
      const unsigned tg = og / nx;
      if (og + 1u == (tg + 1u) * nx) xb_add(&bar[XB_TOPGEN], 1u);
      else XB_SPIN(xb_ld(&bar[XB_TOPGEN]) == tg, bar);
      __builtin_amdgcn_fence(__ATOMIC_ACQUIRE, "agent");
      xb_add(&bar[XB_XGEN(b.x)], 1u);
      asm volatile("s_waitcnt vmcnt(0)" ::: "memory");
    } else {
      XB_SPIN(xb_ld(&bar[XB_XGEN(b.x)]) == gen, bar);
      __builtin_amdgcn_fence(__ATOMIC_ACQUIRE, "agent");
      asm volatile("s_waitcnt vmcnt(0)" ::: "memory");
    }
  }
  __syncthreads();
}

DI void sub_arrive(unsigned* ctr) {
  asm volatile("s_waitcnt vmcnt(0)" ::: "memory");
  __syncthreads();
  if (threadIdx.x == 0) {
    __builtin_amdgcn_fence(__ATOMIC_RELEASE, "agent");
    asm volatile("s_waitcnt vmcnt(0)" ::: "memory");
    (void)__hip_atomic_fetch_add(ctr, 1u, __ATOMIC_RELAXED, __HIP_MEMORY_SCOPE_AGENT);
  }
}
DI void sub_wait(unsigned* ctr, unsigned target) {
  __syncthreads();
  if (threadIdx.x == 0) {
    unsigned sp = 0;
    while (__hip_atomic_load(ctr, __ATOMIC_RELAXED, __HIP_MEMORY_SCOPE_AGENT) < target) { __builtin_amdgcn_s_sleep(1); if (++sp > (1u << 22)) break; }
    __builtin_amdgcn_fence(__ATOMIC_ACQUIRE, "agent");
    asm volatile("s_waitcnt vmcnt(0)" ::: "memory");
  }
  __syncthreads();
}

#ifndef DUP_MASK
#define DUP_MASK 0
#endif
#define REP(bit) for (int rep_ = 0; rep_ < 1 + ((DUP_MASK >> (bit)) & 1); ++rep_)
__global__ __launch_bounds__(NTH) void mega(P p) {
  extern __shared__ __attribute__((aligned(16))) unsigned char shm[];
  cg::grid_group grid = cg::this_grid();
  const int bid = blockIdx.x, nblk = gridDim.x;
  LAS unsigned char* lds = (LAS unsigned char*)shm;
  const CP kp = (CP)__builtin_amdgcn_kernarg_segment_ptr();
  __shared__ uint4 xb_words;
  if (threadIdx.x == 0) xb_words = make_uint4(0u, 0u, 0u, 0u);
  __syncthreads();
  const XcdBarrier xb = xcd_barrier_post(kp->bar, (volatile LAS unsigned*)&xb_words);
#define GSYNC() xcd_barrier(xb)
#define PP launder(kp)
  REP(0) { tconv_range(PP, (float*)shm, 0, 0, TC_L, bid, nblk);
  if (nblk == 256) { for (int l1 = 1; l1 < DEPTH; ++l1) tconv_range(PP, (float*)shm, l1, TC_SPLIT2, TC_L, bid, nblk); }
  lorab_phase(PP, bid, nblk); }
  rope_table_phase(PP, bid);
  { CP p_ = PP; rms_phase<false>(p_->x, p_->norm_g, p_->h, nullptr, bid, nblk); }
  grid.sync();

#pragma unroll 1
  for (int l = 0; l < DEPTH; ++l) {
    REP(1) { CP p_ = PP; EpiProj e{p_->proj}; gemm_phase(lds, p_->h, DM, p_->WtIn + (size_t)l * NP * DM, DM, T, NP, DM, e, bid, nblk); }
    if (l + 1 < DEPTH && nblk == 256 && bid >= 160) tconv_range(PP, (float*)shm, l + 1, 0, TC_SPLIT, bid - 160, 96);
    GSYNC();
    REP(2) for (int u = bid; u < 256; u += nblk) {
      const int e = u >> 7;
      CP p_ = PP;
      EpiLora ep{p_->lw + (size_t)e * T * 1024, p_->w0 + (size_t)(l * 2 + e) * 512, p_->a0 + (size_t)(l * 2 + e) * 512};
      gemm_phase(lds, p_->proj + PIN + e * 256, NP, p_->WtLb + (size_t)(l * 2 + e) * 1024 * 256, 256, T, 1024, 256, ep, u & 127, 128);
    }
    if (nblk < 256) { prep_qkv_phase(PP, l, bid, nblk); prep_vt_phase(PP, bid, nblk); }
    GSYNC();
    if (nblk >= 256) {
      if (bid < 128) { REP(5) scan_item(PP, l, (char*)shm, bid); }
      else {
        REP(2) { prep_qkv_phase(PP, l, bid - 128, nblk - 128); prep_vt_phase(PP, bid - 128, nblk - 128); }
        sub_arrive(kp->bar + XCD_BAR_WORDS);
        REP(4) { prep_a_phase(PP, l, bid - 128, nblk - 128); convd_phase(PP, l, (float*)shm, bid - 128, nblk - 128); }
        sub_wait(kp->bar + XCD_BAR_WORDS, (unsigned)(l + 1) * 128u);
        REP(6) attn_phase(PP, l, (char*)shm, bid - 128, nblk - 128);
        if (l + 1 < DEPTH) tconv_range(PP, (float*)shm, l + 1, TC_SPLIT, TC_SPLIT2, bid - 128, nblk - 128);
      }
    } else {
      for (int it = bid; it < 128; it += nblk) scan_item(PP, l, (char*)shm, it);
      attn_phase(PP, l, (char*)shm, bid, nblk);
      prep_a_phase(PP, l, bid, nblk);
      convd_phase(PP, l, (float*)shm, bid, nblk);
      if (l + 1 < DEPTH) tconv_range(PP, (float*)shm, l + 1, 0, TC_L, bid, nblk);
    }
    GSYNC();
    REP(7) combine_phase(PP, l, bid, nblk);
    GSYNC();
    REP(8) branch_phase(lds, PP, l, bid, nblk);
    GSYNC();
    if ((DUP_MASK >> 10) & 1) GSYNC();
    { CP p_ = PP; EpiOut e{l == 0 ? p_->x : (const float*)p_->xbuf, p_->xbuf}; gemm_phase(lds, p_->mergedb, DM, p_->WtOut + (size_t)l * DM * DM, DM, T, DM, DM, e, bid, nblk); }
    GSYNC();
    if (l < DEPTH - 1) {
      REP(9) { CP p_ = PP; rms_phase<false>(p_->xbuf, p_->norm_g + (size_t)(l + 1) * DM, p_->h, nullptr, bid, nblk); }
      GSYNC();
    } else {
      { CP p_ = PP; rms_phase<true>(p_->xbuf, p_->final_norm_g, nullptr, p_->out, bid, nblk); }
    }
  }
}

extern "C" void kernel_launch(void* const* d_in, const int* in_sizes, int n_in, void* d_out, int out_size, void* d_ws, size_t ws_size, hipStream_t stream) {
  P p{};
  const float** ip = (const float**)&p;
  for (int i = 0; i < 26; ++i) ip[i] = (const float*)d_in[i];
  p.out = (float*)d_out;
  char* w = (char*)d_ws;
  size_t off = 0;
  auto take = [&](size_t bytes) { char* r = w + off; off += (bytes + 255) & ~(size_t)255; return r; };
  p.WtIn = (bf16_t*)take((size_t)DEPTH * NP * DM * 2);
  p.WtBr = (bf16_t*)take((size_t)DEPTH * 4 * DM * BW * 2);
  p.WtOut = (bf16_t*)take((size_t)DEPTH * DM * DM * 2);
  p.WtLb = (bf16_t*)take((size_t)DEPTH * 2 * 1024 * 256 * 2);
  p.h = (bf16_t*)take((size_t)T * DM * 2);
  p.proj = (bf16_t*)take((size_t)T * NP * 2);
  p.qn = (bf16_t*)take((size_t)T * 512 * 2);
  p.kn = (bf16_t*)take((size_t)T * 128 * 2);
  p.vT = (bf16_t*)take((size_t)T * 128 * 2);
  p.ys = (bf16_t*)take((size_t)T * DM * 2);
  p.mergedb = (bf16_t*)take((size_t)T * DM * 2);
  p.lw = (float*)take((size_t)2 * T * 1024 * 4);
  p.SI = (float*)take((size_t)32 * SEQ * 384 * 4);
  p.bonusv = (float*)take((size_t)2 * T * BW * 4);
  p.yraw = (float*)take((size_t)2 * T * BW * 4);
  p.ubuf = (float*)take((size_t)T * BW * 4);
  p.mergedf = (float*)take((size_t)T * DM * 4);
  p.xbuf = (float*)take((size_t)T * DM * 4);
  p.rope = (float*)take((size_t)1024 * 2 * 4);
  p.bar = (unsigned*)take((size_t)(XCD_BAR_WORDS + 64) * 4);
  if (off > ws_size) { fprintf(stderr, "workspace too small: need %zu have %zu\n", off, ws_size); return; }

  static int grid = 0;
  if (!grid) {
    int dev = 0, cus = 0, per_cu = 0;
    (void)hipGetDevice(&dev);
    (void)hipDeviceGetAttribute(&cus, hipDeviceAttributeMultiprocessorCount, dev);
    if (hipFuncSetAttribute((const void*)mega, hipFuncAttributeMaxDynamicSharedMemorySize, GEMM_LDS) != hipSuccess) fprintf(stderr, "hipFuncSetAttribute failed\n");
    if (hipOccupancyMaxActiveBlocksPerMultiprocessor(&per_cu, (const void*)mega, NTH, GEMM_LDS) != hipSuccess || per_cu < 1) { fprintf(stderr, "occupancy query failed (%d)\n", per_cu); per_cu = 1; }
    grid = cus * per_cu;
    if (grid > 256) grid = 256;
  }
  (void)hipMemsetAsync(p.bar, 0, (size_t)(XCD_BAR_WORDS + 64) * 4, stream);
  void* args[] = {&p};
  hipError_t e = hipLaunchCooperativeKernel((const void*)mega, dim3(grid), dim3(NTH), args, GEMM_LDS, stream);
  if (e != hipSuccess) fprintf(stderr, "cooperative launch failed: %s (grid %d)\n", hipGetErrorString(e), grid);
}
```
